# Optimizing an MI355X kernel written in HIP

```python
import math
import jax, jax.numpy as jnp
from jax import lax
import numpy as np

D_MODEL = 1024
BATCH = 4
SEQ = 4096
DEPTH = 1

N_META = 16
RWKV_HEADS = 16
RWKV_HEAD_DIM = 64
RWKV_WIDTH = RWKV_HEADS * RWKV_HEAD_DIM
LORA_W = 64
LORA_A = 64
SB_HEADS = 16
SB_HEAD_DIM = 64
SB_WIDTH = SB_HEADS * SB_HEAD_DIM
SB_BLOCK = 128
N_BRANCH = 2
RWKV_SHIFT_COLS = 3 * RWKV_WIDTH + LORA_W + LORA_A
IN_SIZES = (RWKV_SHIFT_COLS, RWKV_WIDTH, SB_WIDTH, SB_WIDTH, SB_WIDTH, SB_WIDTH, N_BRANCH * D_MODEL)
IN_COLS = RWKV_SHIFT_COLS + RWKV_WIDTH + 4 * SB_WIDTH + N_BRANCH * D_MODEL
RMS_EPS = 1e-6
GN_EPS = 64e-5
L2_EPS = 1e-12
DECAY_SCALE = 0.6065306597126334

kernel_name = "hybrid_rwkv7_stickbreaking_gated_layer"


def _split(t, sizes):
    outs = []
    start = 0
    for size in sizes:
        outs.append(t[..., start:start + size])
        start += size
    return outs


def _rms_norm(t, g):
    t32 = t.astype(jnp.float32)
    inv = lax.rsqrt(jnp.mean(t32 * t32, axis=-1, keepdims=True) + RMS_EPS)
    return (t32 * inv * g.astype(jnp.float32)).astype(t.dtype)


def _heads(t, n_heads):
    return t.reshape(t.shape[:-1] + (n_heads, t.shape[-1] // n_heads))


def _rwkv7_step(state, inputs):
    r, decay, kk, a, k, v = inputs
    sa = jnp.einsum("bhvk,bhk->bhv", state, kk)
    state = (state * decay[:, :, None, :]
             - sa[..., None] * (kk * a)[:, :, None, :]
             + v[..., None] * k[:, :, None, :])
    y = jnp.einsum("bhvk,bhk->bhv", state, r)
    return state, y


def _rwkv7_time_mix(u, mu, w0, w_up, a0, a_up, k_k, k_a, r_k, gn_g, gn_b):
    bsz, length, _ = u.shape
    f32 = jnp.float32
    u_prev = jnp.pad(u, ((0, 0), (1, 0), (0, 0)))[:, :-1]
    u = u + (u_prev - u) * mu
    r, k, v, w_lo, a_lo = _split(u, (RWKV_WIDTH, RWKV_WIDTH, RWKV_WIDTH, LORA_W, LORA_A))
    decay = jnp.exp(-DECAY_SCALE * jax.nn.sigmoid((w0 + jnp.tanh(w_lo) @ w_up).astype(f32)))
    a = jax.nn.sigmoid((a0 + a_lo @ a_up).astype(f32))
    k = k.astype(f32)
    kk = _heads(k * k_k, RWKV_HEADS)
    kk = kk * lax.rsqrt(jnp.sum(kk * kk, axis=-1, keepdims=True) + L2_EPS)
    k = _heads(k * (1.0 + (a - 1.0) * k_a), RWKV_HEADS)
    r = _heads(r.astype(f32), RWKV_HEADS)
    v = _heads(v.astype(f32), RWKV_HEADS)
    decay = _heads(decay, RWKV_HEADS)
    a = _heads(a, RWKV_HEADS)
    state0 = jnp.zeros((bsz, RWKV_HEADS, RWKV_HEAD_DIM, RWKV_HEAD_DIM), f32)
    xs = tuple(jnp.moveaxis(t, 1, 0) for t in (r, decay, kk, a, k, v))
    _, y = lax.scan(_rwkv7_step, state0, xs)
    y = jnp.moveaxis(y, 0, 1)
    mean = jnp.mean(y, axis=-1, keepdims=True)
    var = jnp.mean(jnp.square(y - mean), axis=-1, keepdims=True)
    y = ((y - mean) * lax.rsqrt(var + GN_EPS)).reshape(bsz, length, RWKV_WIDTH) * gn_g + gn_b
    bonus = jnp.sum(r * k * r_k, axis=-1, keepdims=True) * v
    return (y + bonus.reshape(bsz, length, RWKV_WIDTH)).astype(u.dtype)


def _stick_breaking_attention(q, k, v):
    length = q.shape[2]
    scale = SB_HEAD_DIM ** -0.5
    starts = [0] + list(range(N_META, length, SB_BLOCK))
    ends = starts[1:] + [length]
    outs = []
    for qs, qe in zip(starts, ends):
        logits = jnp.einsum("bhqd,bhkd->bhqk", q[:, :, qs:qe], k[:, :, :qe]).astype(jnp.float32) * scale
        visible = jnp.arange(qe)[None, :] < jnp.arange(qs, qe)[:, None]
        log_keep = jnp.where(visible, jax.nn.log_sigmoid(-logits), 0.0)
        log_between = lax.cumsum(log_keep, axis=3, reverse=True) - log_keep
        weights = jnp.where(visible, jnp.exp(jax.nn.log_sigmoid(logits) + log_between), 0.0)
        outs.append(jnp.einsum("bhqk,bhkd->bhqd", weights.astype(v.dtype), v[:, :, :qe]))
    return jnp.concatenate(outs, axis=2)


def setup_inputs(seed: int = 0) -> dict:
    key = jax.random.key(seed)
    ks = jax.random.split(key, 18)
    f32 = jnp.float32

    def nrm(k, shape, s):
        return jax.random.normal(k, shape, f32) * s

    return {
        "x": nrm(ks[0], (BATCH, SEQ, D_MODEL), 1.0),
        "meta_tokens": nrm(ks[1], (N_META, D_MODEL), 1.0),
        "pre_norm_g": 1.0 + nrm(ks[2], (DEPTH, D_MODEL), 0.05),
        "post_norm_g": 1.0 + nrm(ks[3], (DEPTH, D_MODEL), 0.05),
        "w_in": nrm(ks[4], (DEPTH, D_MODEL, IN_COLS), D_MODEL ** -0.5),
        "rwkv_mu": jax.random.uniform(ks[5], (DEPTH, RWKV_SHIFT_COLS), f32),
        "rwkv_w0": nrm(ks[6], (DEPTH, RWKV_WIDTH), 0.5),
        "rwkv_w_up": nrm(ks[7], (DEPTH, LORA_W, RWKV_WIDTH), 0.5 * LORA_W ** -0.5),
        "rwkv_a0": nrm(ks[8], (DEPTH, RWKV_WIDTH), 0.5),
        "rwkv_a_up": nrm(ks[9], (DEPTH, LORA_A, RWKV_WIDTH), 0.5 * LORA_A ** -0.5),
        "rwkv_k_k": 0.85 + nrm(ks[10], (DEPTH, RWKV_WIDTH), 0.05),
        "rwkv_k_a": 1.0 + nrm(ks[11], (DEPTH, RWKV_WIDTH), 0.05),
        "rwkv_r_k": nrm(ks[12], (DEPTH, RWKV_HEADS, RWKV_HEAD_DIM), 0.1),
        "rwkv_gn_g": 1.0 + nrm(ks[13], (DEPTH, RWKV_WIDTH), 0.05),
        "rwkv_gn_b": nrm(ks[14], (DEPTH, RWKV_WIDTH), 0.02),
        "w_proj_rwkv": nrm(ks[15], (DEPTH, RWKV_WIDTH, D_MODEL), RWKV_WIDTH ** -0.5),
        "w_proj_sb": nrm(ks[16], (DEPTH, SB_WIDTH, D_MODEL), SB_WIDTH ** -0.5),
        "w_out": nrm(ks[17], (DEPTH, D_MODEL, D_MODEL), D_MODEL ** -0.5),
    }


def reference(x, meta_tokens, pre_norm_g, post_norm_g, w_in, rwkv_mu, rwkv_w0, rwkv_w_up,
              rwkv_a0, rwkv_a_up, rwkv_k_k, rwkv_k_a, rwkv_r_k, rwkv_gn_g, rwkv_gn_b,
              w_proj_rwkv, w_proj_sb, w_out):
    bsz = x.shape[0]
    meta = jnp.broadcast_to(meta_tokens[None].astype(x.dtype), (bsz, N_META, D_MODEL))
    h = jnp.concatenate([meta, x], axis=1)
    length = h.shape[1]
    for l in range(DEPTH):
        hn = _rms_norm(h, pre_norm_g[l])
        proj = hn @ w_in[l]
        u_rwkv, g_rwkv, q_sb, k_sb, v_sb, g_sb, merge_logits = _split(proj, IN_SIZES)

        y_rwkv = _rwkv7_time_mix(u_rwkv, rwkv_mu[l], rwkv_w0[l], rwkv_w_up[l], rwkv_a0[l],
                                 rwkv_a_up[l], rwkv_k_k[l], rwkv_k_a[l], rwkv_r_k[l],
                                 rwkv_gn_g[l], rwkv_gn_b[l]) * jax.nn.silu(g_rwkv)

        to_bhld = lambda t: jnp.transpose(_heads(t, SB_HEADS), (0, 2, 1, 3))
        o_sb = _stick_breaking_attention(to_bhld(q_sb), to_bhld(k_sb), to_bhld(v_sb))
        y_sb = jnp.transpose(o_sb, (0, 2, 1, 3)).reshape(bsz, length, SB_WIDTH) * jax.nn.silu(g_sb)

        gate_rwkv, gate_sb = _split(jax.nn.sigmoid(merge_logits), (D_MODEL, D_MODEL))
        mixed = gate_rwkv * (y_rwkv @ w_proj_rwkv[l]) + gate_sb * (y_sb @ w_proj_sb[l])
        h = h + _rms_norm(mixed @ w_out[l], post_norm_g[l])
    return h[:, N_META:]
```

```cpp
#include <hip/hip_runtime.h>
#include <cstdio>
#include <cstdint>
namespace pg8 {
#define PG8_LAS __attribute__((address_space(3)))
typedef unsigned short bf16_t;
typedef short bf16x8 __attribute__((ext_vector_type(8)));
typedef float f32x4 __attribute__((ext_vector_type(4)));
typedef unsigned u32x4 __attribute__((ext_vector_type(4)));
constexpr int BM = 256, BK = 64, HALF = 128, HTB = HALF * BK * 2  , STAGE_BYTES = 8 * HTB, NXCD = 8, WGM = 8;

__host__ __device__ __forceinline__ int lds_byte(int r, int c) { const int st = (r >> 4) * 2 + (c >> 5), rr = r & 15, cc = c & 31, ob = rr * 64 + cc * 2; return st * 1024 + (ob ^ (((ob >> 9) & 1) << 5)); }
__host__ __device__ __forceinline__ void stage_rc(int b, int& R, int& C) { const int st = b / 1024, sb = b % 1024, swz = sb ^ (((sb >> 9) & 1) << 5); R = (st >> 1) * 16 + swz / 64; C = (st & 1) * 32 + (swz % 64) / 2; }
__host__ __device__ __forceinline__ int perm32(int rho) { const int n = rho >> 4, i = rho & 15; return 8 * (i >> 2) + 4 * n + (i & 3); }

struct Unit { int pm, pn; };
struct Gemm { const bf16_t* A; const bf16_t* Bt; int M, N, K; };

struct StaticOrder {
    int nM, nN, nwg, G, c;
    __host__ __device__ void init(int M, int N, int G_, int c_) { nM = M / BM; nN = N / BM; nwg = nM * nN; G = G_; c = c_; }
    __host__ __device__ bool next(int i, Unit& u) const {
        const long L = (long)i * G + c; if (L >= nwg) return false;
        int wgid = (int)L; { const int q = nwg / NXCD, r = nwg % NXCD, xcd = wgid % NXCD, off = wgid / NXCD; wgid = (xcd < r ? xcd * (q + 1) : r * (q + 1) + (xcd - r) * q) + off; }
        const int nig = WGM * nN, gid = wgid / nig, fm = gid * WGM, gsz = (nM - fm) < WGM ? (nM - fm) : WGM;
        u.pm = fm + ((wgid % nig) % gsz); u.pn = (wgid % nig) / gsz; return true;
    }
    __device__ __forceinline__ void a_ready(const Unit&) const {}
    __device__ __forceinline__ void done(const Unit&) const {}
};
__device__ __forceinline__ unsigned cvt_pk_bf16(float lo, float hi) { unsigned r; asm volatile("v_cvt_pk_bf16_f32 %0, %1, %2" : "=v"(r) : "v"(lo), "v"(hi)); return r; }
typedef float f32x2 __attribute__((ext_vector_type(2)));
__device__ __forceinline__ float bf_lo(unsigned w) { return __uint_as_float(w << 16); }
__device__ __forceinline__ float bf_hi(unsigned w) { return __uint_as_float(w & 0xffff0000u); }
__device__ __forceinline__ void unpack8(const u32x4 w, float (&f)[8]) { f[0] = bf_lo(w.x); f[1] = bf_hi(w.x); f[2] = bf_lo(w.y); f[3] = bf_hi(w.y); f[4] = bf_lo(w.z); f[5] = bf_hi(w.z); f[6] = bf_lo(w.w); f[7] = bf_hi(w.w); }
__device__ __forceinline__ u32x4 pack8(const float (&f)[8]) { u32x4 w; w.x = cvt_pk_bf16(f[0], f[1]); w.y = cvt_pk_bf16(f[2], f[3]); w.z = cvt_pk_bf16(f[4], f[5]); w.w = cvt_pk_bf16(f[6], f[7]); return w; }
__device__ __forceinline__ float sigmoidf_(float x) { return __builtin_amdgcn_rcpf(1.0f + __builtin_amdgcn_exp2f(-1.4426950408889634f * x)); }

struct EpiStore {
    static constexpr bool PERM = true, AFTER_DRAIN = false;
    bf16_t* base; size_t plane_stride; int qplane; float qscale; int lora_tile; bf16_t* lora;
    __device__ __forceinline__ void operator()(const f32x4 (&acc)[2][2][4][2], const Unit& u, int wr, int wc, int fr, int fq) const {
        bf16_t* dst; int ld, colt; float sc = 1.f;
        if (u.pn == lora_tile) { dst = lora; ld = 256; colt = 0; }
        else { const int pl = u.pn >> 2; dst = base + (size_t)pl * plane_stride; ld = 1024; colt = (u.pn & 3) * 256; if (pl == qplane) sc = qscale; }
        const int row0 = u.pm * BM + wr * 64 + fr, col0 = colt + wc * 32 + 8 * fq;
#pragma unroll
        for (int ai = 0; ai < 2; ++ai)
#pragma unroll
            for (int m = 0; m < 4; ++m) { bf16_t* rowp = dst + (size_t)(row0 + ai * HALF + m * 16) * ld + col0;
#pragma unroll
                for (int bj = 0; bj < 2; ++bj) { const f32x4 v0 = acc[ai][bj][m][0] * sc, v1 = acc[ai][bj][m][1] * sc;
                    u32x4 w; w.x = cvt_pk_bf16(v0[0], v0[1]); w.y = cvt_pk_bf16(v0[2], v0[3]); w.z = cvt_pk_bf16(v1[0], v1[1]); w.w = cvt_pk_bf16(v1[2], v1[3]);
                    *(u32x4*)(rowp + bj * HALF) = w; } }
    }
};

struct EpiGate {
    static constexpr bool PERM = true, AFTER_DRAIN = false;
    bf16_t* YR; bf16_t* O;
    __device__ __forceinline__ void operator()(const f32x4 (&acc)[2][2][4][2], const Unit& u, int wr, int wc, int fr, int fq) const {
        const int row0 = u.pm * BM + wr * 64 + fr;
        bf16_t* Y = (u.pn < 4) ? YR : O;
#pragma unroll
        for (int bj = 0; bj < 2; ++bj) {
            const int col = (u.pn & 3) * 256 + bj * HALF + wc * 32 + 8 * fq;
#pragma unroll
            for (int ai = 0; ai < 2; ++ai)
#pragma unroll
                for (int m = 0; m < 4; ++m) {
                    const int row = row0 + ai * HALF + m * 16; float y[8], o[8];
                    unpack8(*(const u32x4*)(Y + (size_t)row * 1024 + col), y);
#pragma unroll
                    for (int i = 0; i < 8; ++i) { const float g = acc[ai][bj][m][i >> 2][i & 3]; o[i] = y[i] * g * sigmoidf_(g); }
                    *(u32x4*)(Y + (size_t)row * 1024 + col) = pack8(o); asm volatile("" ::: "memory");
                }
        }
    }
};

struct EpiMerge {
    static constexpr bool PERM = true, AFTER_DRAIN = false;
    const bf16_t* Pr; const bf16_t* Ps; bf16_t* MIX;
    __device__ __forceinline__ void operator()(const f32x4 (&acc)[2][2][4][2], const Unit& u, int wr, int wc, int fr, int fq) const {
        const int row0 = u.pm * BM + wr * 64 + fr, col = u.pn * 128 + wc * 32 + 8 * fq;
#pragma unroll
        for (int ai = 0; ai < 2; ++ai)
#pragma unroll
            for (int m = 0; m < 4; ++m) {
                const int row = row0 + ai * HALF + m * 16; float a[8], b[8], o[8];
                unpack8(*(const u32x4*)(Pr + (size_t)row * 1024 + col), a); unpack8(*(const u32x4*)(Ps + (size_t)row * 1024 + col), b);
#pragma unroll
                for (int i = 0; i < 8; ++i) o[i] = sigmoidf_(acc[ai][0][m][i >> 2][i & 3]) * a[i] + sigmoidf_(acc[ai][1][m][i >> 2][i & 3]) * b[i];
                *(u32x4*)(MIX + (size_t)row * 1024 + col) = pack8(o); asm volatile("" ::: "memory");
            }
    }
};

struct EpiOut {
    static constexpr bool PERM = true, AFTER_DRAIN = false;
    bf16_t* RES; float* SSP;
    __device__ __forceinline__ void operator()(const f32x4 (&acc)[2][2][4][2], const Unit& u, int wr, int wc, int fr, int fq) const {
        const int row0 = u.pm * BM + wr * 64 + fr, col0 = u.pn * 256 + wc * 32 + 8 * fq;
#pragma unroll
        for (int ai = 0; ai < 2; ++ai)
#pragma unroll
            for (int m = 0; m < 4; ++m) {
                const int row = row0 + ai * HALF + m * 16; float s = 0.f;
#pragma unroll
                for (int bj = 0; bj < 2; ++bj) { const f32x4 v0 = acc[ai][bj][m][0], v1 = acc[ai][bj][m][1];
                    s += (v0[0] * v0[0] + v0[1] * v0[1]) + (v0[2] * v0[2] + v0[3] * v0[3]) + (v1[0] * v1[0] + v1[1] * v1[1]) + (v1[2] * v1[2] + v1[3] * v1[3]);
                    u32x4 w; w.x = cvt_pk_bf16(v0[0], v0[1]); w.y = cvt_pk_bf16(v0[2], v0[3]); w.z = cvt_pk_bf16(v1[0], v1[1]); w.w = cvt_pk_bf16(v1[2], v1[3]);
                    *(u32x4*)(RES + (size_t)row * 1024 + col0 + bj * HALF) = w; }
                s += __shfl_xor(s, 16); s += __shfl_xor(s, 32);
                if (fq == 0) SSP[(size_t)row * 16 + u.pn * 4 + wc] = s;
            }
    }
};
template <class Epi, class Sched, bool ALIGN_EPI = false, bool SP2 = false>
__device__ __forceinline__ void gemm_phase(PG8_LAS unsigned char* lds, const Gemm g, const Sched& S, const Epi& E) {
    const int tid = threadIdx.x, wid = __builtin_amdgcn_readfirstlane(tid >> 6), lane = tid & 63, wr = wid >> 2, wc = wid & 3, fr = lane & 15, fq = lane >> 4;
    const int K = g.K, nt = K / BK;
    unsigned voffA[2], voffB[2];
#pragma unroll
    for (int i = 0; i < 2; ++i) { int R, C; stage_rc(tid * 16 + i * 8192, R, C); const int Rb = Epi::PERM ? ((R & ~31) + perm32(R & 31)) : R;
        voffA[i] = (unsigned)(R * K + C) * 2u; voffB[i] = (unsigned)(Rb * K + C) * 2u; }
    const size_t kstep = (size_t)(BK * 2);
    const size_t hstep = (size_t)HALF * K * 2;
    const size_t tstep = 2 * hstep;
    const unsigned ldsw = (unsigned)wid * 1024u;
    const int aoff = lds_byte(wr * 64 + fr, fq * 8), boff = lds_byte(wc * 32 + fr, fq * 8);
#define PG8_SA(b, h) (((b) * 2 + (h)) * HTB)
#define PG8_SB(b, h) ((4 + (b) * 2 + (h)) * HTB)
#define PG8_STAGE(bufoff, gbase, voff) do { _Pragma("unroll") for (int _i = 0; _i < 2; ++_i) \
        __builtin_amdgcn_global_load_lds((const unsigned*)((const char*)(gbase) + (voff)[_i]), (PG8_LAS unsigned*)(lds + (bufoff) + ldsw + _i * 8192), 16, 0, 0); } while (0)
#define PG8_LDA(dst, b, h) do { _Pragma("unroll") for (int m = 0; m < 4; ++m) _Pragma("unroll") for (int k = 0; k < 2; ++k) dst[m][k] = *(const PG8_LAS bf16x8*)(lds + PG8_SA(b, h) + aoff + m * 2048 + k * 1024); } while (0)
#define PG8_LDB(dst, b, h) do { _Pragma("unroll") for (int n = 0; n < 2; ++n) _Pragma("unroll") for (int k = 0; k < 2; ++k) dst[n][k] = *(const PG8_LAS bf16x8*)(lds + PG8_SB(b, h) + boff + n * 2048 + k * 1024); } while (0)
#define PG8_MMA(ai, bj, At, Bt) do { __builtin_amdgcn_s_setprio(1); _Pragma("unroll") for (int m = 0; m < 4; ++m) _Pragma("unroll") for (int n = 0; n < 2; ++n) _Pragma("unroll") for (int k = 0; k < 2; ++k) \
        acc[ai][bj][m][n] = __builtin_amdgcn_mfma_f32_16x16x32_bf16(Bt[n][k], At[m][k], acc[ai][bj][m][n], 0, 0, 0); __builtin_amdgcn_s_setprio(0); } while (0)
#define PG8_WAIT_V(n) asm volatile("s_waitcnt vmcnt(" #n ")" ::: "memory")
#define PG8_WAIT_L(n) asm volatile("s_waitcnt lgkmcnt(" #n ")" ::: "memory")
#define PG8_BAR __builtin_amdgcn_s_barrier()
#define PG8_SCHED __builtin_amdgcn_sched_barrier(0)
    Unit cur, nxt; int ui = 0;
    if (!S.next(0, cur)) return;
    f32x4 acc[2][2][4][2];
#pragma unroll
    for (int a = 0; a < 2; ++a)
#pragma unroll
        for (int b = 0; b < 2; ++b)
#pragma unroll
            for (int m = 0; m < 4; ++m)
#pragma unroll
                for (int n = 0; n < 2; ++n) acc[a][b][m][n] = (f32x4){0.f, 0.f, 0.f, 0.f};
    bf16x8 At[4][2], B0[2][2], B1[2][2];
    const char* cA = (const char*)g.A + (size_t)cur.pm * tstep; const char* cB = (const char*)g.Bt + (size_t)cur.pn * tstep;
    S.a_ready(cur);
    if constexpr (SP2) {
        PG8_STAGE(PG8_SB(0, 0), cB, voffB); PG8_STAGE(PG8_SB(0, 1), cB + hstep, voffB); PG8_STAGE(PG8_SA(0, 0), cA, voffA); PG8_STAGE(PG8_SA(0, 1), cA + hstep, voffA);
        if (wr == 1) PG8_BAR;
        PG8_WAIT_V(2); PG8_BAR;
        PG8_STAGE(PG8_SB(1, 0), cB + kstep, voffB); PG8_STAGE(PG8_SA(1, 0), cA + kstep, voffA); PG8_STAGE(PG8_SB(1, 1), cB + hstep + kstep, voffB);
        PG8_WAIT_V(6); PG8_BAR;
    } else {
        PG8_STAGE(PG8_SB(0, 0), cB, voffB); PG8_STAGE(PG8_SA(0, 0), cA, voffA); PG8_STAGE(PG8_SB(0, 1), cB + hstep, voffB); PG8_STAGE(PG8_SA(0, 1), cA + hstep, voffA);
        if (wr == 1) PG8_BAR;
        PG8_WAIT_V(4); PG8_BAR;
        PG8_STAGE(PG8_SB(1, 0), cB + kstep, voffB); PG8_STAGE(PG8_SA(1, 0), cA + kstep, voffA); PG8_STAGE(PG8_SB(1, 1), cB + hstep + kstep, voffB);
        PG8_WAIT_V(6); PG8_BAR;
    }
    for (;;) {
        const bool has_next = S.next(ui + 1, nxt);
        const char* nA = has_next ? (const char*)g.A + (size_t)nxt.pm * tstep : cA; const char* nB = has_next ? (const char*)g.Bt + (size_t)nxt.pn * tstep : cB;
        for (int t = 0; t < nt; t += 2) {
            const bool last = (t == nt - 2);
            const char* a1 = cA + (size_t)(t + 1) * kstep;
            const char* a2 = last ? nA : cA + (size_t)(t + 2) * kstep; const char* b2 = last ? nB : cB + (size_t)(t + 2) * kstep;
            const char* a3 = a2 + kstep; const char* b3 = b2 + kstep;
            if (last && has_next) S.a_ready(nxt);
            if constexpr (SP2) {
            PG8_LDB(B0, 0, 0); PG8_LDB(B1, 0, 1); PG8_SCHED; PG8_LDA(At, 0, 0); PG8_STAGE(PG8_SA(1, 1), a1 + hstep, voffA);
            PG8_WAIT_V(8); PG8_WAIT_L(0); PG8_BAR; PG8_MMA(0, 0, At, B0); PG8_MMA(0, 1, At, B1); PG8_BAR; PG8_SCHED;
            PG8_LDA(At, 0, 1); PG8_STAGE(PG8_SB(0, 0), b2, voffB); PG8_STAGE(PG8_SB(0, 1), b2 + hstep, voffB); PG8_STAGE(PG8_SA(0, 0), a2, voffA);
            PG8_WAIT_V(8); PG8_WAIT_L(0); PG8_BAR; PG8_MMA(1, 0, At, B0); PG8_MMA(1, 1, At, B1); PG8_BAR; PG8_SCHED;
            PG8_LDB(B0, 1, 0); PG8_LDB(B1, 1, 1); PG8_SCHED; PG8_LDA(At, 1, 0); PG8_STAGE(PG8_SA(0, 1), a2 + hstep, voffA);
            PG8_WAIT_V(8); PG8_WAIT_L(0); PG8_BAR; PG8_MMA(0, 0, At, B0); PG8_MMA(0, 1, At, B1); PG8_BAR; PG8_SCHED;
            PG8_LDA(At, 1, 1); PG8_STAGE(PG8_SB(1, 0), b3, voffB); PG8_STAGE(PG8_SB(1, 1), b3 + hstep, voffB); PG8_STAGE(PG8_SA(1, 0), a3, voffA);
            PG8_WAIT_V(8); PG8_WAIT_L(0); PG8_BAR; PG8_MMA(1, 0, At, B0); PG8_MMA(1, 1, At, B1); PG8_BAR; PG8_SCHED;
            } else {
            PG8_LDB(B0, 0, 0); PG8_SCHED; PG8_LDA(At, 0, 0); PG8_STAGE(PG8_SA(1, 1), a1 + hstep, voffA);
            PG8_WAIT_L(8); PG8_BAR; PG8_WAIT_L(0); PG8_MMA(0, 0, At, B0); PG8_BAR; PG8_SCHED;
            PG8_LDB(B1, 0, 1); PG8_STAGE(PG8_SB(0, 0), b2, voffB);
            PG8_BAR; PG8_WAIT_L(0); PG8_MMA(0, 1, At, B1); PG8_BAR;
            PG8_LDA(At, 0, 1); PG8_STAGE(PG8_SA(0, 0), a2, voffA);
            PG8_BAR; PG8_WAIT_L(0); PG8_MMA(1, 0, At, B0); PG8_BAR; PG8_SCHED;
            PG8_STAGE(PG8_SB(0, 1), b2 + hstep, voffB);
            PG8_WAIT_V(6); PG8_BAR; PG8_MMA(1, 1, At, B1); PG8_BAR;
            PG8_LDB(B0, 1, 0); PG8_SCHED; PG8_LDA(At, 1, 0); PG8_STAGE(PG8_SA(0, 1), a2 + hstep, voffA);
            PG8_WAIT_L(8); PG8_BAR; PG8_WAIT_L(0); PG8_MMA(0, 0, At, B0); PG8_BAR; PG8_SCHED;
            PG8_LDB(B1, 1, 1); PG8_STAGE(PG8_SB(1, 0), b3, voffB);
            PG8_BAR; PG8_WAIT_L(0); PG8_MMA(0, 1, At, B1); PG8_BAR;
            PG8_LDA(At, 1, 1); PG8_STAGE(PG8_SA(1, 0), a3, voffA);
            PG8_BAR; PG8_WAIT_L(0); PG8_MMA(1, 0, At, B0); PG8_BAR; PG8_SCHED;
            PG8_STAGE(PG8_SB(1, 1), b3 + hstep, voffB);
            PG8_WAIT_V(6); PG8_BAR; PG8_MMA(1, 1, At, B1); PG8_BAR;
            }
        }
        if constexpr (ALIGN_EPI) { if (wr == 0) PG8_BAR; }
        if constexpr (!Epi::AFTER_DRAIN) { E(acc, cur, wr, wc, fr, fq); S.done(cur); }
        if (!has_next) break;
#pragma unroll
        for (int a = 0; a < 2; ++a)
#pragma unroll
            for (int b = 0; b < 2; ++b)
#pragma unroll
                for (int m = 0; m < 4; ++m)
#pragma unroll
                    for (int n = 0; n < 2; ++n) acc[a][b][m][n] = (f32x4){0.f, 0.f, 0.f, 0.f};
        cur = nxt; cA = nA; cB = nB; ++ui;
        if constexpr (ALIGN_EPI) { if (wr == 1) PG8_BAR; }
    }
    PG8_WAIT_V(0);
    if constexpr (!ALIGN_EPI) { if (wr == 0) PG8_BAR; }
    PG8_BAR;
    if constexpr (Epi::AFTER_DRAIN) { E.fused(acc, cur, wr, wc, fr, fq, lds, wid, lane); S.done(cur); }
#undef PG8_SA
#undef PG8_SB
#undef PG8_STAGE
#undef PG8_LDA
#undef PG8_LDB
#undef PG8_MMA
#undef PG8_WAIT_V
#undef PG8_WAIT_L
#undef PG8_BAR
#undef PG8_SCHED
}
}
#define LAS __attribute__((address_space(3)))
typedef unsigned short bf16;
typedef unsigned u32x4 __attribute__((ext_vector_type(4)));
typedef float f32x4 __attribute__((ext_vector_type(4)));
typedef float f32x16 __attribute__((ext_vector_type(16)));
typedef short bf16x8 __attribute__((ext_vector_type(8)));
typedef short s16x4 __attribute__((ext_vector_type(4)));

constexpr int NB = 4, SEQ = 4096, DM = 1024, NMETA = 16, LTOT = SEQ + NMETA, NH = 16;
constexpr int MR = NB * SEQ;
constexpr int MP = MR + 256;
constexpr int N1 = 6400;
constexpr int NWT = 10496;
constexpr size_t PL = (size_t)MP * 1024 * 2;
constexpr size_t MiB = 1u << 20;
constexpr size_t WS_SSP = 0;
constexpr size_t WS_BONUS = 1 * MiB;
constexpr size_t WS_STAT = 2 * MiB;
constexpr size_t WS_PR = 10 * MiB;
constexpr size_t WS_LORA = WS_PR + 6 * PL;
constexpr size_t WS_XN = WS_LORA + (size_t)MP * 256 * 2;
constexpr size_t WS_END = WS_XN + PL;
static_assert(WS_END <= 256 * MiB, "ws map");
constexpr size_t DO_WTIN = 0;
constexpr size_t DO_WPR = DO_WTIN + (size_t)NWT * 1024 * 2;
constexpr size_t DO_WPS = DO_WPR + 2 * MiB;
constexpr size_t DO_WOUT = DO_WPS + 2 * MiB;
constexpr size_t DO_YR = DO_WOUT + 2 * MiB;
static_assert(DO_YR + (size_t)MR * 1024 * 2 <= (size_t)MR * 1024 * 4, "d_out map");
constexpr size_t WS_SEGS = 2 * MiB;
constexpr size_t WS_CTL = 8 * MiB, CTL_BYTES = 16384;
constexpr int LDS_XB = 147456 - 64;
constexpr size_t WCH = 3072 * 64 * 2;
constexpr size_t DO_WTAIL = DO_YR + (size_t)MR * 1024 * 2;
static_assert(33 * WCH <= (size_t)6400 * 2048 && WS_END + 27 * WCH <= 256 * MiB && DO_WTAIL + 4 * WCH <= (size_t)MR * 1024 * 4 && 64 * 3 * 2 * 16384 <= 8 * MiB, "W / SEGS map");
constexpr int SEG_C0 = 65;
constexpr int LDS_BYTES = 147456;
constexpr float QSCALE = 0.125f * 1.4426950408889634f;

__device__ __forceinline__ unsigned f2bf(float f) { unsigned u = __builtin_bit_cast(unsigned, f); return (u + 0x7fffu + ((u >> 16) & 1u)) >> 16; }
typedef float f32x2_t __attribute__((ext_vector_type(2))); typedef __bf16 bf16x2_t __attribute__((ext_vector_type(2)));
__device__ __forceinline__ unsigned pk2(float lo, float hi) { f32x2_t v = {lo, hi}; bf16x2_t b = __builtin_convertvector(v, bf16x2_t); return __builtin_bit_cast(unsigned, b); }
__device__ __forceinline__ unsigned short f2bfh(float f) { return (unsigned short)(pk2(f, 0.f) & 0xffffu); }
__device__ __forceinline__ float bflo(unsigned w) { return __uint_as_float(w << 16); }
__device__ __forceinline__ float bfhi(unsigned w) { return __uint_as_float(w & 0xffff0000u); }
__device__ __forceinline__ float wave_sum(float v) {
#pragma unroll
    for (int o = 1; o < 64; o <<= 1) v += __shfl_xor(v, o);
    return v;
}
#define LDS_WAIT() asm volatile("s_waitcnt lgkmcnt(0)" ::: "memory")

struct Args {
    const float *x, *meta, *pre_g, *post_g, *w_in, *mu, *w0, *w_up, *a0, *a_up, *k_k, *k_a, *r_k, *gn_g, *gn_b, *w_pr, *w_ps, *w_out;
    float* out; unsigned char* ws; int ph_lo, ph_hi;
};

__device__ __forceinline__ int wtin_src(int r0) {
    if (r0 < 3072) return r0;
    if (r0 < 6144) return 4224 + (r0 - 3072);
    if (r0 < 6272) return 3072 + (r0 - 6144);
    if (r0 < 6400) return -1;
    if (r0 < 7424) return 3200 + (r0 - 6400);
    if (r0 < 8448) return 7296 + (r0 - 7424);
    const int q = r0 - 8448, p = q >> 8, bj = (q >> 7) & 1, i = q & 127;
    return 8320 + 1024 * bj + 128 * p + i;
}
__device__ __forceinline__ void transpose_item(const float* W, int ldw, int srccol, int k0, bf16* WT, int drow, LAS float* scr, int lane) {
    float tv[32];
#pragma unroll
    for (int i = 0; i < 32; ++i) { const int kk = 2 * i + (lane >> 5); tv[i] = srccol >= 0 ? W[(size_t)(k0 + kk) * ldw + srccol + (lane & 31)] : 0.f; }
#pragma unroll
    for (int i = 0; i < 32; ++i) { const int kk = 2 * i + (lane >> 5); scr[kk * 33 + (lane & 31)] = tv[i]; }
    LDS_WAIT(); asm volatile("" ::: "memory");
    const int c = lane & 7;
#pragma unroll
    for (int j = 0; j < 4; ++j) { const int n = (lane >> 3) + 8 * j; const LAS float* s = scr + (8 * c) * 33 + n;
        u32x4 o; o.x = pk2(s[0 * 33], s[1 * 33]); o.y = pk2(s[2 * 33], s[3 * 33]); o.z = pk2(s[4 * 33], s[5 * 33]); o.w = pk2(s[6 * 33], s[7 * 33]);
        *(u32x4*)(WT + (size_t)(drow + n) * 1024 + k0 + 8 * c) = o; }
    LDS_WAIT(); asm volatile("" ::: "memory");
}
__device__ __forceinline__ void p0_prologue(const Args& A, LAS unsigned char* lds, const bool late, const int gw_l, const int ngw_l) {
    const int tid = threadIdx.x, lane = tid & 63, wave = tid >> 6;
    LAS float* scr = (LAS float*)(lds + wave * 16384);
    const int gw = blockIdx.x * 8 + wave, NGW = gridDim.x * 8;
    bf16* WTIN = (bf16*)((unsigned char*)A.out + DO_WTIN); bf16* WPR = (bf16*)((unsigned char*)A.out + DO_WPR); bf16* WPS = (bf16*)((unsigned char*)A.out + DO_WPS); bf16* WOUT = (bf16*)((unsigned char*)A.out + DO_WOUT);
    constexpr int I_IN = (NWT / 32) * 16, I_SQ = 32 * 16, I_EARLY = (N1 / 32) * 16;
    const int it_lo = late ? I_EARLY + gw_l : gw, it_hi = late ? I_IN + 3 * I_SQ : I_EARLY, it_st = late ? ngw_l : NGW;
    for (int it = it_lo; it < it_hi; it += it_st) {
        if (it < I_IN) { const int g = it >> 4, kb = it & 15; transpose_item(A.w_in, 10368, wtin_src(32 * g), 64 * kb, WTIN, 32 * g, scr, lane); }
        else { const int r = it - I_IN, w = r / I_SQ, q = r % I_SQ, g = q >> 4, kb = q & 15;
            transpose_item(w == 0 ? A.w_pr : (w == 1 ? A.w_ps : A.w_out), 1024, 32 * g, 64 * kb, w == 0 ? WPR : (w == 1 ? WPS : WOUT), 32 * g, scr, lane); }
    }
    if (late) return;
    bf16* XN = (bf16*)(A.ws + WS_XN);
    for (int m0 = gw; m0 < MP; m0 += 2 * NGW) {
        f32x4 v[2][4]; float s[2] = {0.f, 0.f};
#pragma unroll
        for (int u = 0; u < 2; ++u) { const int m = m0 + u * NGW;
            if (m < MR + NMETA) { const float* src = (m < MR) ? A.x + (size_t)m * 1024 : A.meta + (size_t)(m - MR) * 1024; const f32x4* xr = (const f32x4*)src + lane;
#pragma unroll
                for (int j = 0; j < 4; ++j) v[u][j] = __builtin_nontemporal_load(xr + 64 * j); }
            else {
#pragma unroll
                for (int j = 0; j < 4; ++j) v[u][j] = (f32x4){0.f, 0.f, 0.f, 0.f}; } }
#pragma unroll
        for (int u = 0; u < 2; ++u)
#pragma unroll
            for (int j = 0; j < 4; ++j) s[u] += (v[u][j].x * v[u][j].x + v[u][j].y * v[u][j].y) + (v[u][j].z * v[u][j].z + v[u][j].w * v[u][j].w);
#pragma unroll
        for (int u = 0; u < 2; ++u) { const int m = m0 + u * NGW; if (m < MP) {
            const float inv = __builtin_amdgcn_rsqf(wave_sum(s[u]) * (1.f / 1024.f) + 1e-6f);
            unsigned long long* o8 = (unsigned long long*)(XN + (size_t)m * 1024) + lane; const f32x4* gr = (const f32x4*)A.pre_g + lane;
#pragma unroll
            for (int j = 0; j < 4; ++j) { const f32x4 g = gr[64 * j]; o8[64 * j] = (unsigned long long)pk2(v[u][j].x * inv * g.x, v[u][j].y * inv * g.y) | ((unsigned long long)pk2(v[u][j].z * inv * g.z, v[u][j].w * inv * g.w) << 32); } } }
    }
}

constexpr int CS = 16, NCHK = LTOT / CS;
typedef short s16x4v __attribute__((ext_vector_type(4)));
__device__ __forceinline__ int tok_row(int b, int t) { return t < NMETA ? MR + t : b * SEQ + t - NMETA; }
__device__ __forceinline__ float dpp_sum16(float x) {
    x += __builtin_bit_cast(float, __builtin_amdgcn_update_dpp(0, __builtin_bit_cast(int, x), 0xB1, 0xF, 0xF, true));
    x += __builtin_bit_cast(float, __builtin_amdgcn_update_dpp(0, __builtin_bit_cast(int, x), 0x4E, 0xF, 0xF, true));
    x += __builtin_bit_cast(float, __builtin_amdgcn_update_dpp(0, __builtin_bit_cast(int, x), 0x141, 0xF, 0xF, true));
    x += __builtin_bit_cast(float, __builtin_amdgcn_update_dpp(0, __builtin_bit_cast(int, x), 0x140, 0xF, 0xF, true));
    return x;
}
__device__ __forceinline__ float wave_sum64(float x) { const float s = dpp_sum16(x); const int si = __builtin_bit_cast(int, s);
    return (__builtin_bit_cast(float, __builtin_amdgcn_readlane(si, 0)) + __builtin_bit_cast(float, __builtin_amdgcn_readlane(si, 16))) + (__builtin_bit_cast(float, __builtin_amdgcn_readlane(si, 32)) + __builtin_bit_cast(float, __builtin_amdgcn_readlane(si, 48))); }
__device__ __forceinline__ s16x4v cvt4(const f32x4 v) { typedef unsigned u32x2_t __attribute__((ext_vector_type(2))); u32x2_t w; w[0] = pk2(v[0], v[1]); w[1] = pk2(v[2], v[3]); return __builtin_bit_cast(s16x4v, w); }
constexpr int SC_SH = 0;
constexpr int SC_LOGD = SC_SH + 20480;
constexpr int SC_AA = SC_LOGD + 4096;
constexpr int SC_KKU = SC_AA + 4096;
constexpr int SC_KP = SC_KKU + 4096;
constexpr int SC_CUM = SC_KP + 4096;
constexpr int SC_SSQ = SC_CUM + 4352;
constexpr int SC_BNP = SC_SSQ + 256;
constexpr int SC_AF = SC_BNP + 256;
constexpr int SC_YOUT = SC_AF + 1024;
constexpr int SC_WOUT = SC_YOUT + 4096;
constexpr int SC_CST = SC_WOUT + 4096;
constexpr int SC_SET = SC_CST + 3072;
constexpr int TMS = 72;
constexpr int ST_AL = 0, ST_RB = 2304, ST_BTM = 4608, ST_KTM = 6912, ST_BT = 9216, ST_KT = 11264, ST_VT = 13312;
constexpr int ST_TT = 15360, ST_BB = 15872, ST_A2 = 16384, ST_B2 = 16896, ST_PC = 17408, ST_BON = 17664, ST_SIZE = 17792;
static_assert(SC_SET + 2 * ST_SIZE <= LDS_BYTES, "scan LDS");

#define LBAR() do { asm volatile("s_waitcnt lgkmcnt(0)" ::: "memory"); __builtin_amdgcn_s_barrier(); asm volatile("" ::: "memory"); } while (0)
__device__ __forceinline__ void scan_chain(const Args& A, LAS unsigned char* lds, const int chain, const int seg) {
    const int c_lo = seg ? SEG_C0 + 64 * (seg - 1) : 0, c_hi = SEG_C0 + 64 * seg;
    const int tid = threadIdx.x, lane = tid & 63, wid = __builtin_amdgcn_readfirstlane(tid >> 6), l15 = lane & 15, q = lane >> 4;
    const int b = chain >> 4, h = chain & 15;
    LAS float* SH = (LAS float*)(lds + SC_SH); LAS float* LOGD = (LAS float*)(lds + SC_LOGD); LAS float* AA = (LAS float*)(lds + SC_AA); LAS float* KKU = (LAS float*)(lds + SC_KKU);
    LAS float* KP = (LAS float*)(lds + SC_KP); LAS float* CUM = (LAS float*)(lds + SC_CUM); LAS float* SSQ = (LAS float*)(lds + SC_SSQ); LAS float* BNP = (LAS float*)(lds + SC_BNP);
    LAS float* AF = (LAS float*)(lds + SC_AF); LAS float* YOUT = (LAS float*)(lds + SC_YOUT); LAS float* WOUT = (LAS float*)(lds + SC_WOUT); LAS float* CST = (LAS float*)(lds + SC_CST);
    const bf16* PR = (const bf16*)(A.ws + WS_PR); const bf16* PK = (const bf16*)(A.ws + WS_PR + PL); const bf16* PV = (const bf16*)(A.ws + WS_PR + 2 * PL);
    const bf16* LORA = (const bf16*)(A.ws + WS_LORA);
    bf16* YR = (bf16*)((unsigned char*)A.out + DO_YR); float* BONUS = (float*)(A.ws + WS_BONUS);
    bf16* Wc = (bf16*)(chain < 33 ? (unsigned char*)A.out + (size_t)chain * WCH : (chain < 60 ? A.ws + WS_END + (size_t)(chain - 33) * WCH : (unsigned char*)A.out + DO_WTAIL + (size_t)(chain - 60) * WCH));
    __syncthreads();
    for (int i = tid; i < 768; i += 512) { const int a = i >> 6, j = i & 63; float v;
        if (a < 3) v = A.mu[a * 1024 + h * 64 + j]; else if (a == 3) v = A.mu[3072 + j]; else if (a == 4) v = A.mu[3136 + j];
        else if (a == 5) v = A.w0[h * 64 + j]; else if (a == 6) v = A.a0[h * 64 + j]; else if (a == 7) v = A.k_k[h * 64 + j]; else if (a == 8) v = A.k_a[h * 64 + j];
        else if (a == 9) v = A.r_k[h * 64 + j]; else if (a == 10) v = A.gn_g[h * 64 + j]; else v = A.gn_b[h * 64 + j];
        CST[i] = v; }
    const int ct = wid & 3;
    bf16x8 bw[2], ba[2];
#pragma unroll
    for (int ks = 0; ks < 2; ++ks)
#pragma unroll
        for (int j = 0; j < 8; ++j) { const int k = 32 * ks + 8 * q + j; const size_t o = (size_t)k * 1024 + h * 64 + 16 * ct + l15;
            bw[ks][j] = (short)f2bf(A.w_up[o]); ba[ks][j] = (short)f2bf(A.a_up[o]); }
    f32x4 sT[4];
#pragma unroll
    for (int m = 0; m < 4; ++m) sT[m] = (f32x4){0.f, 0.f, 0.f, 0.f};
    f32x4 sI[4];
#pragma unroll
    for (int m = 0; m < 4; ++m)
#pragma unroll
        for (int r = 0; r < 4; ++r) sI[m][r] = (16 * m + 4 * q + r == 16 * wid + l15) ? 1.f : 0.f;
    u32x4 pc[2], pp[2];
#define SCAN_ITEMS(I0, I1) const int I0 = (wid < 4) ? tid : ((wid >= 5) ? 448 + (tid - 320) : 0), I1 = (wid < 3) ? tid + 256 : I0
#define SCAN_ISSUE(c0) do { SCAN_ITEMS(i0_, i1_); _Pragma("unroll") for (int qq = 0; qq < 2; ++qq) { const int it = qq ? i1_ : i0_; \
        const int arr = it / (CS * 8), rem = it % (CS * 8), t = rem >> 3, cg = rem & 7; const int tg = (c0) * CS + t; \
        const int rc = tok_row(b, tg), rp = tok_row(b, tg > 0 ? tg - 1 : 0); \
        const bf16* bs = arr == 0 ? PR : (arr == 1 ? PK : (arr == 2 ? PV : LORA)); const int ld = arr < 3 ? 1024 : 256; const int co = arr < 3 ? h * 64 + 8 * cg : (arr == 3 ? 8 * cg : 64 + 8 * cg); \
        pc[qq] = *(const u32x4*)(bs + (size_t)rc * ld + co); pp[qq] = *(const u32x4*)(bs + (size_t)rp * ld + co); } } while (0)
#define SCAN_SHIFT(cc) do { SCAN_ITEMS(i0_, i1_); _Pragma("unroll") for (int qq = 0; qq < 2; ++qq) if (qq == 0 || wid < 3) { const int it = qq ? i1_ : i0_; \
        const int arr = it / (CS * 8), rem = it % (CS * 8), t = rem >> 3, cg = rem & 7; const int tg = (cc) * CS + t; \
        const u32x4 cu = pc[qq]; u32x4 pv = pp[qq]; if (tg == 0) pv = (u32x4){0u, 0u, 0u, 0u}; \
        const float fc[8] = {bflo(cu.x), bfhi(cu.x), bflo(cu.y), bfhi(cu.y), bflo(cu.z), bfhi(cu.z), bflo(cu.w), bfhi(cu.w)}; \
        const float fp[8] = {bflo(pv.x), bfhi(pv.x), bflo(pv.y), bfhi(pv.y), bflo(pv.z), bfhi(pv.z), bflo(pv.w), bfhi(pv.w)}; \
        LAS float* dst = SH + (arr * CS + t) * 64 + 8 * cg; const float* mu = mur[qq]; \
        float sv_[8]; \
        _Pragma("unroll") for (int i = 0; i < 8; ++i) { float v = fc[i] + (fp[i] - fc[i]) * mu[i]; \
            if (arr == 3) { const float e = __builtin_amdgcn_exp2f(2.885390081777927f * v); v = 1.0f - 2.0f * __builtin_amdgcn_rcpf(1.0f + e); } \
            sv_[i] = v; } \
        if (arr < 3) { *(LAS f32x4*)dst = (f32x4){sv_[0], sv_[1], sv_[2], sv_[3]}; *(LAS f32x4*)(dst + 4) = (f32x4){sv_[4], sv_[5], sv_[6], sv_[7]}; } \
        else { *(LAS u32x4*)((LAS bf16*)(SH + 3 * CS * 64) + ((arr - 3) * CS + t) * TMS + 8 * cg) = (u32x4){pk2(sv_[0], sv_[1]), pk2(sv_[2], sv_[3]), pk2(sv_[4], sv_[5]), pk2(sv_[6], sv_[7])}; } } } while (0)
    SCAN_ISSUE(c_lo);
    __syncthreads();
    float mur[2][8];
    { SCAN_ITEMS(i0_, i1_);
#pragma unroll
      for (int qq = 0; qq < 2; ++qq) { const int it = qq ? i1_ : i0_; const int arr = it / (CS * 8), cg = it & 7;
#pragma unroll
        for (int i = 0; i < 8; ++i) mur[qq][i] = CST[arr * 64 + 8 * cg + i]; } }
    if (wid != 4) SCAN_SHIFT(c_lo);
    SCAN_ISSUE(c_lo + 1);
    __syncthreads();
#define SCAN_EPI() do { if (c >= 2) { \
        _Pragma("unroll") for (int i = 0; i < 4; ++i) { const int t = 4 * wid + i; const int tg = (c - 1) * CS + t; const size_t row = (size_t)(b * SEQ + tg - NMETA); \
            YR[row * 1024 + h * 64 + lane] = f2bfh(YOUT[t * 64 + lane]); \
            if (seg) Wc[(size_t)(tg - SEG_C0 * CS) * 64 + lane] = f2bfh(WOUT[t * 64 + lane]); \
            if (lane == 0) BONUS[row * 16 + h] = ((const LAS float*)(setc + ST_BON))[t]; } } } while (0)
    for (int c = c_lo; c <= c_hi; ++c) {
        const bool prod = c < c_hi, cons = c > c_lo;
        LAS unsigned char* setp = lds + SC_SET + (c & 1) * ST_SIZE;
        LAS unsigned char* setc = lds + SC_SET + ((c - 1) & 1) * ST_SIZE;
        if (wid < 4) {
            if (cons) {
                const int row = 16 * wid + l15;
                bf16x8 sb0, sb1;
#pragma unroll
                for (int r = 0; r < 4; ++r) { sb0[r] = cvt4(sT[0])[r]; sb0[4 + r] = cvt4(sT[1])[r]; sb1[r] = cvt4(sT[2])[r]; sb1[4 + r] = cvt4(sT[3])[r]; }
                const LAS bf16* ALr = (const LAS bf16*)(setc + ST_AL) + l15 * TMS; const LAS bf16* RBr = (const LAS bf16*)(setc + ST_RB) + l15 * TMS;
                bf16x8 al0, al1, rb0, rb1;
                { const s16x4v a = *(const LAS s16x4v*)(ALr + 4 * q), b2 = *(const LAS s16x4v*)(ALr + 16 + 4 * q), c2 = *(const LAS s16x4v*)(ALr + 32 + 4 * q), d2 = *(const LAS s16x4v*)(ALr + 48 + 4 * q);
                  al0 = (bf16x8){a[0], a[1], a[2], a[3], b2[0], b2[1], b2[2], b2[3]}; al1 = (bf16x8){c2[0], c2[1], c2[2], c2[3], d2[0], d2[1], d2[2], d2[3]}; }
                { const s16x4v a = *(const LAS s16x4v*)(RBr + 4 * q), b2 = *(const LAS s16x4v*)(RBr + 16 + 4 * q), c2 = *(const LAS s16x4v*)(RBr + 32 + 4 * q), d2 = *(const LAS s16x4v*)(RBr + 48 + 4 * q);
                  rb0 = (bf16x8){a[0], a[1], a[2], a[3], b2[0], b2[1], b2[2], b2[3]}; rb1 = (bf16x8){c2[0], c2[1], c2[2], c2[3], d2[0], d2[1], d2[2], d2[3]}; }
                const s16x4v bb = *(const LAS s16x4v*)((const LAS bf16*)(setc + ST_BB) + l15 * 16 + 4 * q), tt = *(const LAS s16x4v*)((const LAS bf16*)(setc + ST_TT) + l15 * 16 + 4 * q);
                const s16x4v a2 = *(const LAS s16x4v*)((const LAS bf16*)(setc + ST_A2) + l15 * 16 + 4 * q), b2v = *(const LAS s16x4v*)((const LAS bf16*)(setc + ST_B2) + l15 * 16 + 4 * q);
                const int qs = 4 * (q ^ ((l15 >> 2) & 3));
                const s16x4v vt = *(const LAS s16x4v*)((const LAS bf16*)(setc + ST_VT) + row * 16 + qs);
                const f32x4 z4 = {0.f, 0.f, 0.f, 0.f};
                f32x4 rhs = __builtin_amdgcn_mfma_f32_16x16x32_bf16(al0, sb0, z4, 0, 0, 0);
                rhs = __builtin_amdgcn_mfma_f32_16x16x32_bf16(al1, sb1, rhs, 0, 0, 0);
                rhs = __builtin_amdgcn_mfma_f32_16x16x16bf16_1k(bb, vt, rhs, 0, 0, 0);
                f32x4 y = __builtin_amdgcn_mfma_f32_16x16x32_bf16(rb0, sb0, z4, 0, 0, 0);
                y = __builtin_amdgcn_mfma_f32_16x16x32_bf16(rb1, sb1, y, 0, 0, 0);
                y = __builtin_amdgcn_mfma_f32_16x16x16bf16_1k(b2v, vt, y, 0, 0, 0);
                const f32x4 u = __builtin_amdgcn_mfma_f32_16x16x16bf16_1k(tt, cvt4(rhs), z4, 0, 0, 0);
                const s16x4v ub = cvt4(u);
                y = __builtin_amdgcn_mfma_f32_16x16x16bf16_1k(a2, ub, y, 0, 0, 0);
#pragma unroll
                for (int r = 0; r < 4; ++r) YOUT[(4 * q + r) * 64 + row] = y[r];
                bf16x8 ib0, ib1;
                { const s16x4v c0 = cvt4(sI[0]), c1 = cvt4(sI[1]), c2 = cvt4(sI[2]), c3 = cvt4(sI[3]);
                  ib0 = (bf16x8){c0[0], c0[1], c0[2], c0[3], c1[0], c1[1], c1[2], c1[3]}; ib1 = (bf16x8){c2[0], c2[1], c2[2], c2[3], c3[0], c3[1], c3[2], c3[3]}; }
                f32x4 rhsI = __builtin_amdgcn_mfma_f32_16x16x32_bf16(al0, ib0, z4, 0, 0, 0);
                rhsI = __builtin_amdgcn_mfma_f32_16x16x32_bf16(al1, ib1, rhsI, 0, 0, 0);
                f32x4 yI = __builtin_amdgcn_mfma_f32_16x16x32_bf16(rb0, ib0, z4, 0, 0, 0);
                yI = __builtin_amdgcn_mfma_f32_16x16x32_bf16(rb1, ib1, yI, 0, 0, 0);
                const f32x4 uI = __builtin_amdgcn_mfma_f32_16x16x16bf16_1k(tt, cvt4(rhsI), z4, 0, 0, 0);
                const s16x4v ubI = cvt4(uI);
                yI = __builtin_amdgcn_mfma_f32_16x16x16bf16_1k(a2, ubI, yI, 0, 0, 0);
#pragma unroll
                for (int r = 0; r < 4; ++r) WOUT[(4 * q + r) * 64 + row] = yI[r];
#pragma unroll
                for (int m = 0; m < 4; ++m) {
                    const s16x4v btm = *(const LAS s16x4v*)((const LAS bf16*)(setc + ST_BT) + (16 * m + l15) * 16 + qs), ktm = *(const LAS s16x4v*)((const LAS bf16*)(setc + ST_KT) + (16 * m + l15) * 16 + qs);
                    f32x4 s = __builtin_amdgcn_mfma_f32_16x16x16bf16_1k(btm, ub, sT[m], 0, 0, 0);
                    s = __builtin_amdgcn_mfma_f32_16x16x16bf16_1k(ktm, vt, s, 0, 0, 0);
                    const f32x4 pcv = *(const LAS f32x4*)((const LAS float*)(setc + ST_PC) + 16 * m + 4 * q);
                    sT[m] = s * pcv;
                    sI[m] = __builtin_amdgcn_mfma_f32_16x16x16bf16_1k(btm, ubI, sI[m], 0, 0, 0) * pcv;
                }
            }
        } else if (prod) {
            const int ct = wid - 4;
            f32x4 aw = {0.f, 0.f, 0.f, 0.f}, aa = {0.f, 0.f, 0.f, 0.f};
#pragma unroll
            for (int ks = 0; ks < 2; ++ks) {
                const LAS bf16* lw = (const LAS bf16*)(SH + 3 * CS * 64) + l15 * TMS + 32 * ks + 8 * q;
                const bf16x8 fw = *(const LAS bf16x8*)lw, fa = *(const LAS bf16x8*)(lw + CS * TMS);
                aw = __builtin_amdgcn_mfma_f32_16x16x32_bf16(fw, bw[ks], aw, 0, 0, 0);
                aa = __builtin_amdgcn_mfma_f32_16x16x32_bf16(fa, ba[ks], aa, 0, 0, 0);
            }
            const int j = 16 * ct + l15;
            const float w0j = CST[5 * 64 + j], a0j = CST[6 * 64 + j], kkj = CST[7 * 64 + j], kaj = CST[8 * 64 + j], rkj = CST[9 * 64 + j];
            float lg[4];
#pragma unroll
            for (int r = 0; r < 4; ++r) {
                const int t = 4 * q + r;
                const float sgw = __builtin_amdgcn_rcpf(1.0f + __builtin_amdgcn_exp2f(-1.4426950408889634f * (w0j + aw[r])));
                const float a = __builtin_amdgcn_rcpf(1.0f + __builtin_amdgcn_exp2f(-1.4426950408889634f * (a0j + aa[r])));
                const float ksh = SH[(1 * CS + t) * 64 + j], rsh = SH[(0 * CS + t) * 64 + j];
                const float kku = ksh * kkj, kp = ksh * (1.0f + (a - 1.0f) * kaj);
                lg[r] = -0.6065306597126334f * 1.4426950408889634f * sgw; AA[t * 64 + j] = a; KKU[t * 64 + j] = kku; KP[t * 64 + j] = kp;
            }
            { const float cp1 = lg[0], cp2 = cp1 + lg[1], cp3 = cp2 + lg[2], cp4 = cp3 + lg[3];
              LAS float* XQ = SSQ + ct * 64;
              XQ[lane] = cp4; asm volatile("s_waitcnt lgkmcnt(0)" ::: "memory");
              const float g0 = XQ[l15], g1 = XQ[l15 + 16], g2 = XQ[l15 + 32];
              const float off = (q > 0 ? g0 : 0.f) + (q > 1 ? g1 : 0.f) + (q > 2 ? g2 : 0.f);
              const float cpr[5] = {off, off + cp1, off + cp2, off + cp3, off + cp4};
#pragma unroll
              for (int r = 0; r < 4; ++r) { CUM[(4 * q + r) * 64 + j] = cpr[r]; LOGD[(4 * q + r) * 64 + j] = cpr[r + 1]; } }
        }
        LBAR();
        if (!prod) {
            if (wid < 4) { SCAN_EPI(); }
            LBAR();
            break;
        }
        { const int t0 = tid >> 6, k = tid & 63;
#pragma unroll
          for (int i = 0; i < 2; ++i) { const int t = t0 + 8 * i, e = t * 64 + k;
            const float kku_ = KKU[e], rsh_ = SH[(0 * CS + t) * 64 + k];
            const float rs = __builtin_amdgcn_rsqf(wave_sum64(kku_ * kku_) + 1e-12f), bon_ = wave_sum64(rsh_ * KP[e] * CST[9 * 64 + k]);
            const float c0 = CUM[e], c1 = LOGD[e];
            const float e0 = __builtin_amdgcn_exp2f(c0), e1 = __builtin_amdgcn_exp2f(c1), ie1 = __builtin_amdgcn_exp2f(-c1);
            const float kk = kku_ * rs;
            const unsigned w01 = pk2(kk * e0, rsh_ * e1), w23 = pk2(-kk * AA[e] * ie1, KP[e] * ie1); const bf16 al = (bf16)(w01 & 0xffffu), rb = (bf16)(w01 >> 16), bt = (bf16)(w23 & 0xffffu), kt = (bf16)(w23 >> 16);
            { const int et = t * TMS + k; ((LAS bf16*)(setp + ST_AL))[et] = al; ((LAS bf16*)(setp + ST_RB))[et] = rb; ((LAS bf16*)(setp + ST_BTM))[et] = bt; ((LAS bf16*)(setp + ST_KTM))[et] = kt; }
            const int tsw = 4 * ((t >> 2) ^ ((k >> 2) & 3)) + (t & 3);
            ((LAS bf16*)(setp + ST_BT))[k * 16 + tsw] = bt; ((LAS bf16*)(setp + ST_KT))[k * 16 + tsw] = kt;
            ((LAS bf16*)(setp + ST_VT))[k * 16 + tsw] = f2bfh(SH[(2 * CS + t) * 64 + k]);
            if (t == CS - 1) ((LAS float*)(setp + ST_PC))[k] = e1;
            if (k == 0) ((LAS float*)(setp + ST_BON))[t] = bon_; } }
        LBAR();
        if (wid >= 4) { const int p = wid - 4;
            const LAS bf16* ALr = (const LAS bf16*)(setp + ST_AL) + l15 * TMS; const LAS bf16* RBr = (const LAS bf16*)(setp + ST_RB) + l15 * TMS;
            const LAS bf16* BTr = (const LAS bf16*)(setp + ST_BTM) + l15 * TMS; const LAS bf16* KTr = (const LAS bf16*)(setp + ST_KTM) + l15 * TMS;
            const f32x4 z4 = {0.f, 0.f, 0.f, 0.f};
            if (p == 0) {
                f32x4 xt = z4, xa = z4;
#pragma unroll
                for (int ks = 0; ks < 2; ++ks) { const bf16x8 a = *(const LAS bf16x8*)(ALr + 32 * ks + 8 * q), bq = *(const LAS bf16x8*)(BTr + 32 * ks + 8 * q);
                    xt = __builtin_amdgcn_mfma_f32_16x16x32_bf16(a, bq, xt, 0, 0, 0); xa = __builtin_amdgcn_mfma_f32_16x16x32_bf16(bq, a, xa, 0, 0, 0); }
                f32x4 idn;
#pragma unroll
                for (int r = 0; r < 4; ++r) { const int rr = 4 * q + r; xt[r] = (l15 < rr) ? xt[r] : 0.f; xa[r] = (rr < l15) ? xa[r] : 0.f; idn[r] = (rr == l15) ? 1.f : 0.f; }
                s16x4v X = cvt4(xa), XT = cvt4(xt);
                f32x4 Tm = xa + idn, TmT = xt + idn;
                f32x4 x2 = __builtin_amdgcn_mfma_f32_16x16x16bf16_1k(XT, X, z4, 0, 0, 0), x2t = __builtin_amdgcn_mfma_f32_16x16x16bf16_1k(X, XT, z4, 0, 0, 0);
                s16x4v X2 = cvt4(x2), X2T = cvt4(x2t);
                { const s16x4v t1 = cvt4(Tm), t1t = cvt4(TmT);
                  Tm = __builtin_amdgcn_mfma_f32_16x16x16bf16_1k(t1t, X2, Tm, 0, 0, 0); TmT = __builtin_amdgcn_mfma_f32_16x16x16bf16_1k(X2, t1t, TmT, 0, 0, 0); }
                f32x4 x4 = __builtin_amdgcn_mfma_f32_16x16x16bf16_1k(X2T, X2, z4, 0, 0, 0), x4t = __builtin_amdgcn_mfma_f32_16x16x16bf16_1k(X2, X2T, z4, 0, 0, 0);
                s16x4v X4 = cvt4(x4), X4T = cvt4(x4t);
                { const s16x4v t2t = cvt4(TmT);
                  Tm = __builtin_amdgcn_mfma_f32_16x16x16bf16_1k(t2t, X4, Tm, 0, 0, 0); TmT = __builtin_amdgcn_mfma_f32_16x16x16bf16_1k(X4, t2t, TmT, 0, 0, 0); }
                const f32x4 x8 = __builtin_amdgcn_mfma_f32_16x16x16bf16_1k(X4T, X4, z4, 0, 0, 0);
                { const s16x4v t4t = cvt4(TmT), X8 = cvt4(x8);
                  Tm = __builtin_amdgcn_mfma_f32_16x16x16bf16_1k(t4t, X8, Tm, 0, 0, 0); }
                *(LAS s16x4v*)((LAS bf16*)(setp + ST_TT) + l15 * 16 + 4 * q) = cvt4(Tm);
            } else {
                const LAS bf16* Lm = (p == 1) ? ALr : RBr; const LAS bf16* Rm = (p == 2) ? BTr : KTr;
                f32x4 x = z4;
#pragma unroll
                for (int ks = 0; ks < 2; ++ks) x = __builtin_amdgcn_mfma_f32_16x16x32_bf16(*(const LAS bf16x8*)(Lm + 32 * ks + 8 * q), *(const LAS bf16x8*)(Rm + 32 * ks + 8 * q), x, 0, 0, 0);
#pragma unroll
                for (int r = 0; r < 4; ++r) { const int t = 4 * q + r; const bool keep = (p == 1) ? (l15 < t) : (l15 <= t);
                    ((LAS bf16*)(setp + (p == 1 ? ST_BB : (p == 2 ? ST_A2 : ST_B2))))[t * 16 + l15] = f2bfh(keep ? x[r] : 0.f); }
            }
        }
        if (wid < 4 && cons) { SCAN_EPI(); }
        if (wid != 4 && c + 1 < c_hi) SCAN_SHIFT(c + 1);
        { const int cn = c + 2 < c_hi ? c + 2 : c_hi - 1; SCAN_ISSUE(cn); }
        LBAR();
    }
#undef SCAN_SHIFT
#undef SCAN_ITEMS
#undef SCAN_EPI
#undef SCAN_ISSUE
    if (wid < 4 && seg < 3) { float* sg = (float*)(A.ws + WS_SEGS) + (size_t)((chain * 3 + seg) * 2) * 4096 + (16 * wid + l15) * 64 + 4 * q;
#pragma unroll
        for (int m = 0; m < 4; ++m) { *(f32x4*)(sg + 16 * m) = sT[m]; *(f32x4*)(sg + 4096 + 16 * m) = sI[m]; } }
}

__device__ __forceinline__ int crow(int r, int hi) { return (r & 3) + 8 * (r >> 2) + 4 * hi; }
__device__ __forceinline__ int slot_key(int i) { const int i5 = i & 31; return (i & 32) + 16 * ((i5 >> 2) & 1) + (i5 & 3) + 4 * (i5 >> 3); }
constexpr int AT_K = 0, AT_V = 8192, AT_FLAG = 16384;
__device__ __forceinline__ void attn_phase(const Args& A, LAS unsigned char* lds) {
    const int tid = threadIdx.x, lane = tid & 63, r32 = lane & 31, hi = lane >> 5, wid = __builtin_amdgcn_readfirstlane(tid >> 6);
    bf16* Q = (bf16*)(A.ws + WS_PR + 3 * PL); const bf16* K = (const bf16*)(A.ws + WS_PR + 4 * PL); const bf16* V = (const bf16*)(A.ws + WS_PR + 5 * PL);
    LAS float* FLAG = (LAS float*)(lds + AT_FLAG);
    const int vb = (int)(unsigned)(uintptr_t)(lds + AT_V) + ((lane >> 4) & 1) * 32 + (lane & 3) * 8 + (4 * hi + ((lane & 15) >> 2)) * 64;
    const int kslot = slot_key(lane);
    const int vslot = slot_key(16 * (wid & 3) + (lane >> 2));
    unsigned* qctr = (unsigned*)(A.ws + WS_CTL) + 4000;
    LAS int* UQ = (LAS int*)(lds + AT_FLAG + 64);
    for (;;) {
        __syncthreads();
        if (tid == 0) *UQ = (int)atomicAdd(qctr, 1u);
        __syncthreads();
        const int unit = *UQ; if (unit >= NB * NH * 16) break;
        const int bh = unit & 63, qb = 15 - (unit >> 6), b = bh >> 4, h = bh & 15;
        const int tq0 = NMETA + 256 * qb, tqw = tq0 + 32 * wid;
        const int uqw = 256 * qb + 32 * wid, uq = uqw + r32;
        const bf16* Qw = Q + (size_t)(b * SEQ + tqw - NMETA) * 1024 + h * 64;
        bf16x8 qr[4];
#pragma unroll
        for (int d0 = 0; d0 < 4; ++d0) qr[d0] = *(const bf16x8*)(Qw + (size_t)r32 * 1024 + d0 * 16 + hi * 8);
        f32x16 o0 = {}, o1 = {}; float c = 1.f;
        const int jmax = 4 * qb + 3;
        u32x4 kreg, vreg;
#define AT_LOAD(j) do { const size_t rk_ = (j) >= 0 ? (size_t)(b * SEQ + 64 * (j) + kslot) : (size_t)(MR + (kslot < NMETA ? kslot : NMETA - 1)), rv_ = (j) >= 0 ? (size_t)(b * SEQ + 64 * (j) + vslot) : (size_t)(MR + (vslot < NMETA ? vslot : NMETA - 1)); \
            kreg = *(const u32x4*)(K + rk_ * 1024 + h * 64 + 8 * wid); vreg = *(const u32x4*)(V + rv_ * 1024 + h * 64 + (wid >> 2) * 32 + (lane & 3) * 8); } while (0)
        AT_LOAD(jmax);
        if (lane == 0) FLAG[wid] = 1.f;
        for (int j = jmax; j >= -1; --j) {
            __syncthreads();
            { float fm = FLAG[0];
#pragma unroll
              for (int i = 1; i < 8; ++i) fm = fmaxf(fm, FLAG[i]);
              if (fm < 1.17549435e-38f) break; }
            *(LAS u32x4*)(lds + AT_K + wid * 1024 + lane * 16) = kreg; *(LAS u32x4*)(lds + AT_V + wid * 1024 + lane * 16) = vreg;
            { const int jn = j > -1 ? j - 1 : -1; AT_LOAD(jn); }
            __syncthreads();
            if (64 * j > uqw + 31) continue;
            f32x16 p0 = {}, p1 = {};
            { const LAS unsigned char* kb = lds + AT_K + hi * 1024 + r32 * 16;
#pragma unroll
              for (int d0 = 0; d0 < 4; ++d0) { const bf16x8 b0 = *(const LAS bf16x8*)(kb + d0 * 2048), b1 = *(const LAS bf16x8*)(kb + d0 * 2048 + 512);
                  p0 = __builtin_amdgcn_mfma_f32_32x32x16_bf16(b0, qr[d0], p0, 0, 0, 0); p1 = __builtin_amdgcn_mfma_f32_32x32x16_bf16(b1, qr[d0], p1, 0, 0, 0); } }
            const int kbase = (j >= 0 ? 64 * j : 0) + 16 * hi, tq = j >= 0 ? uq : NMETA;
            float T0 = 1.f, T1 = 1.f;
#define AT_ELEM(MASKED) do { \
            _Pragma("unroll") for (int r = 15; r >= 0; --r) { const float e = __builtin_amdgcn_exp2f(fminf(p1[r], 100.f)); float kp = __builtin_amdgcn_rcpf(1.0f + e), be = e * kp; \
                if (MASKED) { if (kbase + 32 + r >= tq) { kp = 1.f; be = 0.f; } } p1[r] = be * T1; T1 *= kp; } \
            _Pragma("unroll") for (int r = 15; r >= 0; --r) { const float e = __builtin_amdgcn_exp2f(fminf(p0[r], 100.f)); float kp = __builtin_amdgcn_rcpf(1.0f + e), be = e * kp; \
                if (MASKED) { if (kbase + r >= tq) { kp = 1.f; be = 0.f; } } p0[r] = be * T0; T0 *= kp; } } while (0)
            if (j < 0 || 64 * j + 63 >= uqw) AT_ELEM(1); else AT_ELEM(0);
#undef AT_ELEM
            float PT0, PT1;
            { auto r0 = __builtin_amdgcn_permlane32_swap(__float_as_uint(T0), __float_as_uint(T0), false, false); PT0 = __uint_as_float(hi ? r0[0] : r0[1]);
              auto r1 = __builtin_amdgcn_permlane32_swap(__float_as_uint(T1), __float_as_uint(T1), false, false); PT1 = __uint_as_float(hi ? r1[0] : r1[1]); }
            const float off0 = c * (hi ? (T1 * PT1) : (PT0 * T1 * PT1)), off1 = c * (hi ? 1.f : PT1);
#pragma unroll
            for (int r = 0; r < 16; ++r) { p0[r] *= off0; p1[r] *= off1; }
            c *= (T0 * T1) * (PT0 * PT1);
            { float cm = c;
              cm = fmaxf(cm, __builtin_bit_cast(float, __builtin_amdgcn_update_dpp(0, __builtin_bit_cast(int, cm), 0xB1, 0xF, 0xF, true)));
              cm = fmaxf(cm, __builtin_bit_cast(float, __builtin_amdgcn_update_dpp(0, __builtin_bit_cast(int, cm), 0x4E, 0xF, 0xF, true)));
              cm = fmaxf(cm, __builtin_bit_cast(float, __builtin_amdgcn_update_dpp(0, __builtin_bit_cast(int, cm), 0x141, 0xF, 0xF, true)));
              cm = fmaxf(cm, __builtin_bit_cast(float, __builtin_amdgcn_update_dpp(0, __builtin_bit_cast(int, cm), 0x140, 0xF, 0xF, true)));
              const float c0 = __builtin_bit_cast(float, __builtin_amdgcn_readlane(__builtin_bit_cast(int, cm), 0)), c1 = __builtin_bit_cast(float, __builtin_amdgcn_readlane(__builtin_bit_cast(int, cm), 16));
              if (lane == 0) FLAG[wid] = fmaxf(c0, c1); }
            u32x4 pw0, pw1, pw2, pw3;
            pw0 = (u32x4){pk2(p0[0], p0[1]), pk2(p0[2], p0[3]), pk2(p0[4], p0[5]), pk2(p0[6], p0[7])}; pw1 = (u32x4){pk2(p0[8], p0[9]), pk2(p0[10], p0[11]), pk2(p0[12], p0[13]), pk2(p0[14], p0[15])};
            pw2 = (u32x4){pk2(p1[0], p1[1]), pk2(p1[2], p1[3]), pk2(p1[4], p1[5]), pk2(p1[6], p1[7])}; pw3 = (u32x4){pk2(p1[8], p1[9]), pk2(p1[10], p1[11]), pk2(p1[12], p1[13]), pk2(p1[14], p1[15])};
#pragma unroll
            for (int d0 = 0; d0 < 2; ++d0) { s16x4 lo[4], hh[4];
#pragma unroll
                for (int ks = 0; ks < 4; ++ks) {
                    asm volatile("ds_read_b64_tr_b16 %0,%1 offset:%c2" : "=&v"(lo[ks]) : "v"(vb), "i"(d0 * 4096 + ks * 1024) : "memory");
                    asm volatile("ds_read_b64_tr_b16 %0,%1 offset:%c2" : "=&v"(hh[ks]) : "v"(vb), "i"(d0 * 4096 + ks * 1024 + 512) : "memory"); }
                asm volatile("s_waitcnt lgkmcnt(0)" ::: "memory"); __builtin_amdgcn_sched_barrier(0);
#define PKV(k) (bf16x8){lo[k][0], lo[k][1], lo[k][2], lo[k][3], hh[k][0], hh[k][1], hh[k][2], hh[k][3]}
                f32x16& o = d0 ? o1 : o0;
                o = __builtin_amdgcn_mfma_f32_32x32x16_bf16(__builtin_bit_cast(bf16x8, pw0), PKV(0), o, 0, 0, 0);
                o = __builtin_amdgcn_mfma_f32_32x32x16_bf16(__builtin_bit_cast(bf16x8, pw1), PKV(1), o, 0, 0, 0);
                o = __builtin_amdgcn_mfma_f32_32x32x16_bf16(__builtin_bit_cast(bf16x8, pw2), PKV(2), o, 0, 0, 0);
                o = __builtin_amdgcn_mfma_f32_32x32x16_bf16(__builtin_bit_cast(bf16x8, pw3), PKV(3), o, 0, 0, 0);
#undef PKV
            }
        }
#undef AT_LOAD
        bf16* Ow = Q + (size_t)(b * SEQ + tqw - NMETA) * 1024 + h * 64;
#pragma unroll
        for (int r = 0; r < 16; ++r) { const int orow = crow(r, hi); Ow[(size_t)orow * 1024 + r32] = (bf16)f2bf(o0[r]); Ow[(size_t)orow * 1024 + 32 + r32] = (bf16)f2bf(o1[r]); }
        __syncthreads();
    }
}

__device__ __forceinline__ void corr_phase(const Args& A, LAS unsigned char* lds) {
    const int tid = threadIdx.x, lane = tid & 63, wid = __builtin_amdgcn_readfirstlane(tid >> 6), l15 = lane & 15, q = lane >> 4;
    LAS float* SA = (LAS float*)lds; LAS float* SB = SA + 4096;
    bf16* YR = (bf16*)((unsigned char*)A.out + DO_YR); const float* BONUS = (const float*)(A.ws + WS_BONUS);
    const bf16* V = (const bf16*)(A.ws + WS_PR + 2 * PL); const float* SEGS = (const float*)(A.ws + WS_SEGS);
    for (int task = blockIdx.x; task < NB * NH * 4; task += gridDim.x) {
        const int chain = task >> 2, seg = task & 3, b = chain >> 4, h = chain & 15;
        const int c_lo = seg ? SEG_C0 + 64 * (seg - 1) : 0, c_hi = SEG_C0 + 64 * seg;
        const bf16* Wc = (const bf16*)(chain < 33 ? (unsigned char*)A.out + (size_t)chain * WCH : (chain < 60 ? A.ws + WS_END + (size_t)(chain - 33) * WCH : (unsigned char*)A.out + DO_WTAIL + (size_t)(chain - 60) * WCH));
        __syncthreads();
        for (int i = tid; i < 4096; i += 512) SA[i] = seg ? SEGS[(size_t)((chain * 3) * 2) * 4096 + i] : 0.f;
        __syncthreads();
        LAS float* cur = SA; LAS float* nxt = SB;
        for (int s2 = 1; s2 < seg; ++s2) {
            const float* S0 = SEGS + (size_t)((chain * 3 + s2) * 2) * 4096; const float* Cm = S0 + 4096;
            const int row = tid >> 3, kb = (tid & 7) * 8;
            f32x4 a0 = *(const f32x4*)(S0 + row * 64 + kb), a1 = *(const f32x4*)(S0 + row * 64 + kb + 4);
#pragma unroll 8
            for (int j = 0; j < 64; ++j) { const float s = cur[row * 64 + j]; const f32x4 c0 = *(const f32x4*)(Cm + j * 64 + kb), c1 = *(const f32x4*)(Cm + j * 64 + kb + 4); a0 += c0 * s; a1 += c1 * s; }
            *(LAS f32x4*)(nxt + row * 64 + kb) = a0; *(LAS f32x4*)(nxt + row * 64 + kb + 4) = a1;
            __syncthreads();
            LAS float* tsw = cur; cur = nxt; nxt = tsw;
        }
        bf16x8 sinB[4][2];
#pragma unroll
        for (int m = 0; m < 4; ++m)
#pragma unroll
            for (int ks = 0; ks < 2; ++ks) { const LAS float* sp = cur + (16 * m + l15) * 64 + 32 * ks + 8 * q; const s16x4v c0 = cvt4(*(const LAS f32x4*)sp), c1 = cvt4(*(const LAS f32x4*)(sp + 4));
                sinB[m][ks] = (bf16x8){c0[0], c0[1], c0[2], c0[3], c1[0], c1[1], c1[2], c1[3]}; }
        const int colb = h * 64 + l15;
        float mv[4], gg[4], gb[4];
#pragma unroll
        for (int m = 0; m < 4; ++m) { mv[m] = A.mu[2048 + colb + 16 * m]; gg[m] = A.gn_g[colb + 16 * m]; gb[m] = A.gn_b[colb + 16 * m]; }
        const int cfirst = c_lo > 1 ? c_lo : 1;
#define CORR_LOAD(ck, W0, W1, YV, VT, VP, BN) do { \
            const bf16* wr_ = seg ? Wc + (size_t)(((ck) - SEG_C0) * CS + l15) * 64 + 8 * q : (const bf16*)SEGS; W0 = *(const bf16x8*)wr_; W1 = *(const bf16x8*)(wr_ + 32); \
            _Pragma("unroll") for (int r = 0; r < 4; ++r) { const int tg_ = (ck) * CS + 4 * q + r; const size_t row_ = (size_t)(b * SEQ + tg_ - NMETA), prow_ = (tg_ == NMETA) ? (size_t)(MR + NMETA - 1) : row_ - 1; \
                BN[r] = BONUS[row_ * 16 + h]; \
                _Pragma("unroll") for (int m = 0; m < 4; ++m) { YV[r][m] = YR[row_ * 1024 + colb + 16 * m]; VT[r][m] = V[row_ * 1024 + colb + 16 * m]; VP[r][m] = V[prow_ * 1024 + colb + 16 * m]; } } } while (0)
        const int nit = (c_hi - cfirst - wid + 7) / 8;
        if (nit > 0) {
            bf16x8 w0c, w1c; bf16 yc[4][4], vtc[4][4], vpc[4][4]; float bnc[4];
            CORR_LOAD(cfirst + wid, w0c, w1c, yc, vtc, vpc, bnc);
            for (int it = 0; it < nit; ++it) {
                const int chk = cfirst + wid + 8 * it, cn = (it + 1 < nit) ? chk + 8 : chk;
                bf16x8 w0n, w1n; bf16 yn[4][4], vtn[4][4], vpn[4][4]; float bnn[4];
                CORR_LOAD(cn, w0n, w1n, yn, vtn, vpn, bnn);
                f32x4 acc[4];
#pragma unroll
                for (int m = 0; m < 4; ++m) acc[m] = (f32x4){0.f, 0.f, 0.f, 0.f};
                if (seg) {
#pragma unroll
                    for (int m = 0; m < 4; ++m) { acc[m] = __builtin_amdgcn_mfma_f32_16x16x32_bf16(w0c, sinB[m][0], acc[m], 0, 0, 0); acc[m] = __builtin_amdgcn_mfma_f32_16x16x32_bf16(w1c, sinB[m][1], acc[m], 0, 0, 0); } }
#pragma unroll
                for (int r = 0; r < 4; ++r) { const int tg = chk * CS + 4 * q + r; const size_t row = (size_t)(b * SEQ + tg - NMETA);
                    float y[4]; float s = 0.f;
#pragma unroll
                    for (int m = 0; m < 4; ++m) { y[m] = bflo((unsigned)yc[r][m]) + acc[m][r]; s += y[m]; }
                    const float mean = dpp_sum16(s) * (1.f / 64.f); float sq = 0.f;
#pragma unroll
                    for (int m = 0; m < 4; ++m) { y[m] -= mean; sq += y[m] * y[m]; }
                    const float rstd = __builtin_amdgcn_rsqf(dpp_sum16(sq) * (1.f / 64.f) + 64e-5f);
#pragma unroll
                    for (int m = 0; m < 4; ++m) { const float vt = bflo((unsigned)vtc[r][m]), vp = bflo((unsigned)vpc[r][m]); const float vs = vt + (vp - vt) * mv[m]; YR[row * 1024 + colb + 16 * m] = f2bfh(y[m] * rstd * gg[m] + gb[m] + bnc[r] * vs); }
                }
                w0c = w0n; w1c = w1n;
#pragma unroll
                for (int r = 0; r < 4; ++r) { bnc[r] = bnn[r];
#pragma unroll
                    for (int m = 0; m < 4; ++m) { yc[r][m] = yn[r][m]; vtc[r][m] = vtn[r][m]; vpc[r][m] = vpn[r][m]; } }
            }
        }
#undef CORR_LOAD
    }
}

__device__ __forceinline__ void final_phase(const Args& A) {
    const int tid = threadIdx.x, lane = tid & 63, wave = tid >> 6;
    const bf16* RES = (const bf16*)(A.ws + WS_PR); const float* SSP = (const float*)(A.ws + WS_SSP);
    for (int m0 = blockIdx.x * 8 + wave; m0 < MR; m0 += gridDim.x * 16) {
        f32x4 xv[2][4], rv[2][4]; float ss[2] = {0.f, 0.f};
#pragma unroll
        for (int u = 0; u < 2; ++u) { const int m = m0 + u * gridDim.x * 8; if (m < MR) {
            const f32x4* xr = (const f32x4*)(A.x + (size_t)m * 1024) + lane; const unsigned long long* rr = (const unsigned long long*)(RES + (size_t)m * 1024) + lane;
#pragma unroll
            for (int j = 0; j < 4; ++j) { xv[u][j] = __builtin_nontemporal_load(xr + 64 * j); const unsigned long long w = __builtin_nontemporal_load(rr + 64 * j); const unsigned lo = (unsigned)w, hi = (unsigned)(w >> 32); rv[u][j] = (f32x4){bflo(lo), bfhi(lo), bflo(hi), bfhi(hi)}; }
            const f32x4* sp = (const f32x4*)(SSP + (size_t)m * 16);
#pragma unroll
            for (int i = 0; i < 4; ++i) { const f32x4 t = sp[i]; ss[u] += (t[0] + t[1]) + (t[2] + t[3]); } } }
#pragma unroll
        for (int u = 0; u < 2; ++u) { const int m = m0 + u * gridDim.x * 8; if (m < MR) {
            const float inv = __builtin_amdgcn_rsqf(ss[u] * (1.f / 1024.f) + 1e-6f);
            const f32x4* gr = (const f32x4*)A.post_g + lane; f32x4* orow = (f32x4*)(A.out + (size_t)m * 1024) + lane;
#pragma unroll
            for (int j = 0; j < 4; ++j) __builtin_nontemporal_store(xv[u][j] + rv[u][j] * inv * gr[64 * j], orow + 64 * j); } }
    }
}

#define XB_TMO      128
#define XB_XCNT(j)  (256  + 64 * (j))
#define XB_XSUB(j)  (1280 + 64 * (j))
#define XB_XGEN(j)  (2304 + 64 * (j))
#define XB_TOP      3328
#define XB_TOPGEN   3392
#define XCD_BAR_WORDS 3456
#define XB_SPIN_CAP (1u << 18)

__device__ __forceinline__ unsigned xb_ld(unsigned* p)              { return __hip_atomic_load(p, __ATOMIC_RELAXED, __HIP_MEMORY_SCOPE_AGENT); }
__device__ __forceinline__ unsigned xb_add(unsigned* p, unsigned v) { return __hip_atomic_fetch_add(p, v, __ATOMIC_RELAXED, __HIP_MEMORY_SCOPE_AGENT); }
__device__ __forceinline__ unsigned xb_xcc_id() { return (unsigned)__builtin_amdgcn_s_getreg((3 << 11) | 20) & 0xFu; }
#define XB_SPIN(cond, bar) do { unsigned _sp = 0; while (cond) { __builtin_amdgcn_s_sleep(1); \
    if ((++_sp & 255u) == 0u) { if (xb_ld(&(bar)[XB_TMO])) break; if (_sp > XB_SPIN_CAP) { atomicAdd(&(bar)[XB_TMO], 1u); break; } } } } while (0)

struct XcdBarrier {
    unsigned* bar; unsigned x;
    volatile LAS unsigned* st;
};

__device__ __forceinline__ XcdBarrier xcd_barrier_post(unsigned* bar, volatile LAS unsigned* st) {
    XcdBarrier b; b.bar = bar; b.x = xb_xcc_id(); b.st = st;
    if (threadIdx.x == 0) (void)xb_add(&bar[XB_XCNT(b.x)], 1u);
    return b;
}
__device__ __forceinline__ void xcd_barrier_complete(unsigned* bar, unsigned x, unsigned& nloc, unsigned& nx) {
    const unsigned G = gridDim.x * gridDim.y * gridDim.z;
    unsigned sum, cnt, mine, sp = 0u;
    for (;;) {
        sum = 0u; cnt = 0u; mine = 0u;
#pragma unroll
        for (unsigned j = 0; j < 16; ++j) { const unsigned c = xb_ld(&bar[XB_XCNT(j)]); sum += c; cnt += (c > 0u) ? 1u : 0u; mine = (j == x) ? c : mine; }
        if (sum == G) break;
        __builtin_amdgcn_s_sleep(1);
        if ((++sp & 255u) == 0u) { if (xb_ld(&bar[XB_TMO])) break; if (sp > XB_SPIN_CAP) { atomicAdd(&bar[XB_TMO], 1u); break; } }
    }
    nloc = mine > 0u ? mine : 1u; nx = cnt > 0u ? cnt : 1u;
}

__device__ __forceinline__ void xcd_barrier(const XcdBarrier& b) {
    asm volatile("s_waitcnt vmcnt(0)" ::: "memory");
    __syncthreads();
    if (threadIdx.x == 0) {
        unsigned* bar = b.bar;
        __builtin_amdgcn_s_waitcnt(0);
        unsigned nloc = b.st[0], nx = b.st[1];
        if (nloc == 0u) { xcd_barrier_complete(bar, b.x, nloc, nx); b.st[0] = nloc; b.st[1] = nx; }
        const unsigned old = xb_add(&bar[XB_XSUB(b.x)], 1u);
        const unsigned gen = old / nloc;
        if (old + 1u == (gen + 1u) * nloc) {
            __builtin_amdgcn_fence(__ATOMIC_RELEASE, "agent");
            asm volatile("s_waitcnt vmcnt(0)" ::: "memory");
            const unsigned og = xb_add(&bar[XB_TOP], 1u);
            const unsigned tg = og / nx;
            if (og + 1u == (tg + 1u) * nx) xb_add(&bar[XB_TOPGEN], 1u);
            else XB_SPIN(xb_ld(&bar[XB_TOPGEN]) == tg, bar);
            __builtin_amdgcn_fence(__ATOMIC_ACQUIRE, "agent");
            xb_add(&bar[XB_XGEN(b.x)], 1u);
            asm volatile("s_waitcnt vmcnt(0)" ::: "memory");
        } else {
            XB_SPIN(xb_ld(&bar[XB_XGEN(b.x)]) == gen, bar);
            __builtin_amdgcn_fence(__ATOMIC_ACQUIRE, "agent");
            asm volatile("s_waitcnt vmcnt(0)" ::: "memory");
        }
    }
    __syncthreads();
}

constexpr int NPH = 9;
__global__ void __launch_bounds__(512, 2) fwd_kernel(Args A) {
    extern __shared__ __attribute__((aligned(16))) unsigned char lds_raw[];
    LAS unsigned char* lds = (LAS unsigned char*)lds_raw;
    unsigned char* ws = A.ws; unsigned char* dob = (unsigned char*)A.out;
    const bf16* XN = (const bf16*)(ws + WS_XN); const bf16* WTIN = (const bf16*)(dob + DO_WTIN);
    bf16* P0 = (bf16*)(ws + WS_PR);
#define IN(k) (A.ph_lo <= (k) && (k) < A.ph_hi)
    if (threadIdx.x < 16) ((LAS unsigned*)(lds + LDS_XB))[threadIdx.x] = 0u;
    __syncthreads();
    const XcdBarrier xbar = xcd_barrier_post((unsigned*)(ws + WS_CTL), (volatile LAS unsigned*)(lds + LDS_XB));
#define SEAM(k) do { if (IN(k) && IN((k) + 1)) xcd_barrier(xbar); } while (0)
    if (IN(0)) p0_prologue(A, lds, false, 0, 1);
    SEAM(0);
    if (IN(1)) {
        pg8::Gemm g{XN, WTIN, MP, N1, 1024}; pg8::StaticOrder S; S.init(MP, N1, gridDim.x, blockIdx.x);
        pg8::EpiStore E{P0, PL / 2, 3, QSCALE, 24, (bf16*)(ws + WS_LORA)};
        pg8::gemm_phase<pg8::EpiStore, pg8::StaticOrder, true, true>(lds, g, S, E);
        { const int nun = (MP / 256) * (N1 / 256), rem = nun % (int)gridDim.x; const int first = (rem > 0 && rem < (int)gridDim.x) ? rem : 0;
          __syncthreads();
          if ((int)blockIdx.x >= first) p0_prologue(A, lds, true, ((int)blockIdx.x - first) * 8 + (int)(threadIdx.x >> 6), ((int)gridDim.x - first) * 8); }
    }
    SEAM(1);
    if (IN(2)) { for (int task = blockIdx.x; task < NB * NH * 4; task += gridDim.x) scan_chain(A, lds, task >> 2, task & 3); __syncthreads(); attn_phase(A, lds); }
    SEAM(2);
    if (IN(3)) corr_phase(A, lds);
    SEAM(3);
    if (IN(4)) {
        pg8::Gemm g{XN, WTIN + (size_t)6400 * 1024, MR, 2048, 1024}; pg8::StaticOrder S; S.init(MR, 2048, gridDim.x, blockIdx.x);
        pg8::EpiGate E{(bf16*)(dob + DO_YR), P0 + 3 * (PL / 2)};
        pg8::gemm_phase<pg8::EpiGate, pg8::StaticOrder, true, true>(lds, g, S, E);
    }
    SEAM(4);
    if (IN(5)) {
        { pg8::Gemm g{(const bf16*)(dob + DO_YR), (const bf16*)(dob + DO_WPR), MR, 1024, 1024}; pg8::StaticOrder S; S.init(MR, 1024, gridDim.x, blockIdx.x);
          pg8::EpiStore E{P0 + 1 * (PL / 2), 0, -1, 1.f, -1, nullptr}; pg8::gemm_phase<pg8::EpiStore, pg8::StaticOrder, true, true>(lds, g, S, E); }
        { pg8::Gemm g{P0 + 3 * (PL / 2), (const bf16*)(dob + DO_WPS), MR, 1024, 1024}; pg8::StaticOrder S; S.init(MR, 1024, gridDim.x, blockIdx.x);
          pg8::EpiStore E{P0 + 4 * (PL / 2), 0, -1, 1.f, -1, nullptr}; pg8::gemm_phase<pg8::EpiStore, pg8::StaticOrder, true, true>(lds, g, S, E); }
    }
    SEAM(5);
    if (IN(6)) {
        pg8::Gemm g{XN, WTIN + (size_t)8448 * 1024, MR, 2048, 1024}; pg8::StaticOrder S; S.init(MR, 2048, gridDim.x, blockIdx.x);
        pg8::EpiMerge E{P0 + 1 * (PL / 2), P0 + 4 * (PL / 2), P0 + 2 * (PL / 2)};
        pg8::gemm_phase<pg8::EpiMerge, pg8::StaticOrder, true, true>(lds, g, S, E);
    }
    SEAM(6);
    if (IN(7)) {
        pg8::Gemm g{P0 + 2 * (PL / 2), (const bf16*)(dob + DO_WOUT), MR, 1024, 1024}; pg8::StaticOrder S; S.init(MR, 1024, gridDim.x, blockIdx.x);
        pg8::EpiOut E{(bf16*)(ws + WS_PR), (float*)(ws + WS_SSP)};
        pg8::gemm_phase<pg8::EpiOut, pg8::StaticOrder, true, true>(lds, g, S, E);
    }
    SEAM(7);
    if (IN(8)) final_phase(A);
#undef IN
#undef SEAM
}

#ifndef N_LAUNCHES
#define N_LAUNCHES 1
#endif
extern "C" void kernel_launch(void* const* d_in, const int* in_sizes, int n_in, void* d_out, int out_size, void* d_ws, size_t ws_size, hipStream_t stream) {
    static int grid = 0;
    if (grid == 0) {
        int dev = 0, cus = 0, per_cu = 0;
        hipGetDevice(&dev); hipDeviceGetAttribute(&cus, hipDeviceAttributeMultiprocessorCount, dev);
        hipFuncSetAttribute((const void*)fwd_kernel, hipFuncAttributeMaxDynamicSharedMemorySize, LDS_BYTES);
        if (hipOccupancyMaxActiveBlocksPerMultiprocessor(&per_cu, (const void*)fwd_kernel, 512, LDS_BYTES) != hipSuccess || per_cu < 1) per_cu = 1;
        (void)hipGetLastError();
        grid = cus * per_cu; if (grid > 256) grid = 256;
        if (n_in != 18 || ws_size < WS_END) { fprintf(stderr, "kernel_launch: unexpected inputs (n_in %d, ws %zu)\n", n_in, ws_size); }
    }
    (void)hipMemsetAsync((unsigned char*)d_ws + WS_CTL, 0, CTL_BYTES, stream);
    Args a{};
    const float** pf = (const float**)&a;
    for (int i = 0; i < 18; ++i) pf[i] = (const float*)d_in[i];
    a.out = (float*)d_out; a.ws = (unsigned char*)d_ws;
    for (int li = 0; li < N_LAUNCHES; ++li) {
        a.ph_lo = (N_LAUNCHES == 1) ? 0 : li; a.ph_hi = (N_LAUNCHES == 1) ? NPH : li + 1;
        void* args[] = {&a};
        hipError_t e = hipLaunchCooperativeKernel((const void*)fwd_kernel, dim3(grid), dim3(512), args, LDS_BYTES, stream);
        if (e != hipSuccess) { fprintf(stderr, "cooperative launch failed: %s (grid %d)\n", hipGetErrorString(e), grid); break; }
    }
}
```

```cpp
#include <hip/hip_runtime.h>
#include <cstdio>
#include <cstdint>
namespace pg8 {
#define PG8_LAS __attribute__((address_space(3)))
typedef unsigned short bf16_t;
typedef short bf16x8 __attribute__((ext_vector_type(8)));
typedef float f32x4 __attribute__((ext_vector_type(4)));
typedef unsigned u32x4 __attribute__((ext_vector_type(4)));
constexpr int BM = 256, BK = 64, HALF = 128, HTB = HALF * BK * 2  , STAGE_BYTES = 8 * HTB, NXCD = 8, WGM = 8;

__host__ __device__ __forceinline__ int lds_byte(int r, int c) { const int st = (r >> 4) * 2 + (c >> 5), rr = r & 15, cc = c & 31, ob = rr * 64 + cc * 2; return st * 1024 + (ob ^ (((ob >> 9) & 1) << 5)); }
__host__ __device__ __forceinline__ void stage_rc(int b, int& R, int& C) { const int st = b / 1024, sb = b % 1024, swz = sb ^ (((sb >> 9) & 1) << 5); R = (st >> 1) * 16 + swz / 64; C = (st & 1) * 32 + (swz % 64) / 2; }
__host__ __device__ __forceinline__ int perm32(int rho) { const int n = rho >> 4, i = rho & 15; return 8 * (i >> 2) + 4 * n + (i & 3); }

struct Unit { int pm, pn; };
struct Gemm { const bf16_t* A; const bf16_t* Bt; int M, N, K; };

struct StaticOrder {
    int nM, nN, nwg, G, c;
    __host__ __device__ void init(int M, int N, int G_, int c_) { nM = M / BM; nN = N / BM; nwg = nM * nN; G = G_; c = c_; }
    __host__ __device__ bool next(int i, Unit& u) const {
        const long L = (long)i * G + c; if (L >= nwg) return false;
        int wgid = (int)L; { const int q = nwg / NXCD, r = nwg % NXCD, xcd = wgid % NXCD, off = wgid / NXCD; wgid = (xcd < r ? xcd * (q + 1) : r * (q + 1) + (xcd - r) * q) + off; }
        const int nig = WGM * nN, gid = wgid / nig, fm = gid * WGM, gsz = (nM - fm) < WGM ? (nM - fm) : WGM;
        u.pm = fm + ((wgid % nig) % gsz); u.pn = (wgid % nig) / gsz; return true;
    }
    __device__ __forceinline__ void a_ready(const Unit&) const {}
    __device__ __forceinline__ void done(const Unit&) const {}
};
__device__ __forceinline__ unsigned cvt_pk_bf16(float lo, float hi) { unsigned r; asm volatile("v_cvt_pk_bf16_f32 %0, %1, %2" : "=v"(r) : "v"(lo), "v"(hi)); return r; }
typedef float f32x2 __attribute__((ext_vector_type(2)));
__device__ __forceinline__ float bf_lo(unsigned w) { return __uint_as_float(w << 16); }
__device__ __forceinline__ float bf_hi(unsigned w) { return __uint_as_float(w & 0xffff0000u); }
__device__ __forceinline__ void unpack8(const u32x4 w, float (&f)[8]) { f[0] = bf_lo(w.x); f[1] = bf_hi(w.x); f[2] = bf_lo(w.y); f[3] = bf_hi(w.y); f[4] = bf_lo(w.z); f[5] = bf_hi(w.z); f[6] = bf_lo(w.w); f[7] = bf_hi(w.w); }
__device__ __forceinline__ u32x4 pack8(const float (&f)[8]) { u32x4 w; w.x = cvt_pk_bf16(f[0], f[1]); w.y = cvt_pk_bf16(f[2], f[3]); w.z = cvt_pk_bf16(f[4], f[5]); w.w = cvt_pk_bf16(f[6], f[7]); return w; }
__device__ __forceinline__ float sigmoidf_(float x) { return __builtin_amdgcn_rcpf(1.0f + __builtin_amdgcn_exp2f(-1.4426950408889634f * x)); }

struct EpiStore {
    static constexpr bool PERM = true, AFTER_DRAIN = false;
    bf16_t* base; size_t plane_stride; int qplane; float qscale; int lora_tile; bf16_t* lora;
    __device__ __forceinline__ void operator()(const f32x4 (&acc)[2][2][4][2], const Unit& u, int wr, int wc, int fr, int fq) const {
        bf16_t* dst; int ld, colt; float sc = 1.f;
        if (u.pn == lora_tile) { dst = lora; ld = 256; colt = 0; }
        else { const int pl = u.pn >> 2; dst = base + (size_t)pl * plane_stride; ld = 1024; colt = (u.pn & 3) * 256; if (pl == qplane) sc = qscale; }
        const int row0 = u.pm * BM + wr * 64 + fr, col0 = colt + wc * 32 + 8 * fq;
#pragma unroll
        for (int ai = 0; ai < 2; ++ai)
#pragma unroll
            for (int m = 0; m < 4; ++m) { bf16_t* rowp = dst + (size_t)(row0 + ai * HALF + m * 16) * ld + col0;
#pragma unroll
                for (int bj = 0; bj < 2; ++bj) { const f32x4 v0 = acc[ai][bj][m][0] * sc, v1 = acc[ai][bj][m][1] * sc;
                    u32x4 w; w.x = cvt_pk_bf16(v0[0], v0[1]); w.y = cvt_pk_bf16(v0[2], v0[3]); w.z = cvt_pk_bf16(v1[0], v1[1]); w.w = cvt_pk_bf16(v1[2], v1[3]);
                    *(u32x4*)(rowp + bj * HALF) = w; } }
    }
};

struct EpiGate {
    static constexpr bool PERM = true, AFTER_DRAIN = false;
    bf16_t* YR; bf16_t* O;
    __device__ __forceinline__ void operator()(const f32x4 (&acc)[2][2][4][2], const Unit& u, int wr, int wc, int fr, int fq) const {
        const int row0 = u.pm * BM + wr * 64 + fr;
        bf16_t* Y = (u.pn < 4) ? YR : O;
#pragma unroll
        for (int bj = 0; bj < 2; ++bj) {
            const int col = (u.pn & 3) * 256 + bj * HALF + wc * 32 + 8 * fq;
#pragma unroll
            for (int ai = 0; ai < 2; ++ai)
#pragma unroll
                for (int m = 0; m < 4; ++m) {
                    const int row = row0 + ai * HALF + m * 16; float y[8], o[8];
                    unpack8(*(const u32x4*)(Y + (size_t)row * 1024 + col), y);
#pragma unroll
                    for (int i = 0; i < 8; ++i) { const float g = acc[ai][bj][m][i >> 2][i & 3]; o[i] = y[i] * g * sigmoidf_(g); }
                    *(u32x4*)(Y + (size_t)row * 1024 + col) = pack8(o); asm volatile("" ::: "memory");
                }
        }
    }
};

struct EpiMerge {
    static constexpr bool PERM = true, AFTER_DRAIN = false;
    const bf16_t* Pr; const bf16_t* Ps; bf16_t* MIX;
    __device__ __forceinline__ void operator()(const f32x4 (&acc)[2][2][4][2], const Unit& u, int wr, int wc, int fr, int fq) const {
        const int row0 = u.pm * BM + wr * 64 + fr, col = u.pn * 128 + wc * 32 + 8 * fq;
#pragma unroll
        for (int ai = 0; ai < 2; ++ai)
#pragma unroll
            for (int m = 0; m < 4; ++m) {
                const int row = row0 + ai * HALF + m * 16; float a[8], b[8], o[8];
                unpack8(*(const u32x4*)(Pr + (size_t)row * 1024 + col), a); unpack8(*(const u32x4*)(Ps + (size_t)row * 1024 + col), b);
#pragma unroll
                for (int i = 0; i < 8; ++i) o[i] = sigmoidf_(acc[ai][0][m][i >> 2][i & 3]) * a[i] + sigmoidf_(acc[ai][1][m][i >> 2][i & 3]) * b[i];
                *(u32x4*)(MIX + (size_t)row * 1024 + col) = pack8(o); asm volatile("" ::: "memory");
            }
    }
};

struct EpiOut {
    static constexpr bool PERM = true, AFTER_DRAIN = false;
    bf16_t* RES; float* SSP;
    __device__ __forceinline__ void operator()(const f32x4 (&acc)[2][2][4][2], const Unit& u, int wr, int wc, int fr, int fq) const {
        const int row0 = u.pm * BM + wr * 64 + fr, col0 = u.pn * 256 + wc * 32 + 8 * fq;
#pragma unroll
        for (int ai = 0; ai < 2; ++ai)
#pragma unroll
            for (int m = 0; m < 4; ++m) {
                const int row = row0 + ai * HALF + m * 16; float s = 0.f;
#pragma unroll
                for (int bj = 0; bj < 2; ++bj) { const f32x4 v0 = acc[ai][bj][m][0], v1 = acc[ai][bj][m][1];
                    s += (v0[0] * v0[0] + v0[1] * v0[1]) + (v0[2] * v0[2] + v0[3] * v0[3]) + (v1[0] * v1[0] + v1[1] * v1[1]) + (v1[2] * v1[2] + v1[3] * v1[3]);
                    u32x4 w; w.x = cvt_pk_bf16(v0[0], v0[1]); w.y = cvt_pk_bf16(v0[2], v0[3]); w.z = cvt_pk_bf16(v1[0], v1[1]); w.w = cvt_pk_bf16(v1[2], v1[3]);
                    *(u32x4*)(RES + (size_t)row * 1024 + col0 + bj * HALF) = w; }
                s += __shfl_xor(s, 16); s += __shfl_xor(s, 32);
                if (fq == 0) SSP[(size_t)row * 16 + u.pn * 4 + wc] = s;
            }
    }
};
template <class Epi, class Sched, bool ALIGN_EPI = false, bool SP2 = false>
__device__ __forceinline__ void gemm_phase(PG8_LAS unsigned char* lds, const Gemm g, const Sched& S, const Epi& E) {
    const int tid = threadIdx.x, wid = __builtin_amdgcn_readfirstlane(tid >> 6), lane = tid & 63, wr = wid >> 2, wc = wid & 3, fr = lane & 15, fq = lane >> 4;
    const int K = g.K, nt = K / BK;
    unsigned voffA[2], voffB[2];
#pragma unroll
    for (int i = 0; i < 2; ++i) { int R, C; stage_rc(tid * 16 + i * 8192, R, C); const int Rb = Epi::PERM ? ((R & ~31) + perm32(R & 31)) : R;
        voffA[i] = (unsigned)(R * K + C) * 2u; voffB[i] = (unsigned)(Rb * K + C) * 2u; }
    const size_t kstep = (size_t)(BK * 2);
    const size_t hstep = (size_t)HALF * K * 2;
    const size_t tstep = 2 * hstep;
    const unsigned ldsw = (unsigned)wid * 1024u;
    const int aoff = lds_byte(wr * 64 + fr, fq * 8), boff = lds_byte(wc * 32 + fr, fq * 8);
#define PG8_SA(b, h) (((b) * 2 + (h)) * HTB)
#define PG8_SB(b, h) ((4 + (b) * 2 + (h)) * HTB)
#define PG8_STAGE(bufoff, gbase, voff) do { _Pragma("unroll") for (int _i = 0; _i < 2; ++_i) \
        __builtin_amdgcn_global_load_lds((const unsigned*)((const char*)(gbase) + (voff)[_i]), (PG8_LAS unsigned*)(lds + (bufoff) + ldsw + _i * 8192), 16, 0, 0); } while (0)
#define PG8_LDA(dst, b, h) do { _Pragma("unroll") for (int m = 0; m < 4; ++m) _Pragma("unroll") for (int k = 0; k < 2; ++k) dst[m][k] = *(const PG8_LAS bf16x8*)(lds + PG8_SA(b, h) + aoff + m * 2048 + k * 1024); } while (0)
#define PG8_LDB(dst, b, h) do { _Pragma("unroll") for (int n = 0; n < 2; ++n) _Pragma("unroll") for (int k = 0; k < 2; ++k) dst[n][k] = *(const PG8_LAS bf16x8*)(lds + PG8_SB(b, h) + boff + n * 2048 + k * 1024); } while (0)
#define PG8_MMA(ai, bj, At, Bt) do { __builtin_amdgcn_s_setprio(1); _Pragma("unroll") for (int m = 0; m < 4; ++m) _Pragma("unroll") for (int n = 0; n < 2; ++n) _Pragma("unroll") for (int k = 0; k < 2; ++k) \
        acc[ai][bj][m][n] = __builtin_amdgcn_mfma_f32_16x16x32_bf16(Bt[n][k], At[m][k], acc[ai][bj][m][n], 0, 0, 0); __builtin_amdgcn_s_setprio(0); } while (0)
#define PG8_WAIT_V(n) asm volatile("s_waitcnt vmcnt(" #n ")" ::: "memory")
#define PG8_WAIT_L(n) asm volatile("s_waitcnt lgkmcnt(" #n ")" ::: "memory")
#define PG8_BAR __builtin_amdgcn_s_barrier()
#define PG8_SCHED __builtin_amdgcn_sched_barrier(0)
    Unit cur, nxt; int ui = 0;
    if (!S.next(0, cur)) return;
    f32x4 acc[2][2][4][2];
#pragma unroll
    for (int a = 0; a < 2; ++a)
#pragma unroll
        for (int b = 0; b < 2; ++b)
#pragma unroll
            for (int m = 0; m < 4; ++m)
#pragma unroll
                for (int n = 0; n < 2; ++n) acc[a][b][m][n] = (f32x4){0.f, 0.f, 0.f, 0.f};
    bf16x8 At[4][2], B0[2][2], B1[2][2];
    const char* cA = (const char*)g.A + (size_t)cur.pm * tstep; const char* cB = (const char*)g.Bt + (size_t)cur.pn * tstep;
    S.a_ready(cur);
    if constexpr (SP2) {
        PG8_STAGE(PG8_SB(0, 0), cB, voffB); PG8_STAGE(PG8_SB(0, 1), cB + hstep, voffB); PG8_STAGE(PG8_SA(0, 0), cA, voffA); PG8_STAGE(PG8_SA(0, 1), cA + hstep, voffA);
        if (wr == 1) PG8_BAR;
        PG8_WAIT_V(2); PG8_BAR;
        PG8_STAGE(PG8_SB(1, 0), cB + kstep, voffB); PG8_STAGE(PG8_SA(1, 0), cA + kstep, voffA); PG8_STAGE(PG8_SB(1, 1), cB + hstep + kstep, voffB);
        PG8_WAIT_V(6); PG8_BAR;
    } else {
        PG8_STAGE(PG8_SB(0, 0), cB, voffB); PG8_STAGE(PG8_SA(0, 0), cA, voffA); PG8_STAGE(PG8_SB(0, 1), cB + hstep, voffB); PG8_STAGE(PG8_SA(0, 1), cA + hstep, voffA);
        if (wr == 1) PG8_BAR;
        PG8_WAIT_V(4); PG8_BAR;
        PG8_STAGE(PG8_SB(1, 0), cB + kstep, voffB); PG8_STAGE(PG8_SA(1, 0), cA + kstep, voffA); PG8_STAGE(PG8_SB(1, 1), cB + hstep + kstep, voffB);
        PG8_WAIT_V(6); PG8_BAR;
    }
    for (;;) {
        const bool has_next = S.next(ui + 1, nxt);
        const char* nA = has_next ? (const char*)g.A + (size_t)nxt.pm * tstep : cA; const char* nB = has_next ? (const char*)g.Bt + (size_t)nxt.pn * tstep : cB;
        for (int t = 0; t < nt; t += 2) {
            const bool last = (t == nt - 2);
            const char* a1 = cA + (size_t)(t + 1) * kstep;
            const char* a2 = last ? nA : cA + (size_t)(t + 2) * kstep; const char* b2 = last ? nB : cB + (size_t)(t + 2) * kstep;
            const char* a3 = a2 + kstep; const char* b3 = b2 + kstep;
            if (last && has_next) S.a_ready(nxt);
            if constexpr (SP2) {
            PG8_LDB(B0, 0, 0); PG8_LDB(B1, 0, 1); PG8_SCHED; PG8_LDA(At, 0, 0); PG8_STAGE(PG8_SA(1, 1), a1 + hstep, voffA);
            PG8_WAIT_V(8); PG8_WAIT_L(0); PG8_BAR; PG8_MMA(0, 0, At, B0); PG8_MMA(0, 1, At, B1); PG8_BAR; PG8_SCHED;
            PG8_LDA(At, 0, 1); PG8_STAGE(PG8_SB(0, 0), b2, voffB); PG8_STAGE(PG8_SB(0, 1), b2 + hstep, voffB); PG8_STAGE(PG8_SA(0, 0), a2, voffA);
            PG8_WAIT_V(8); PG8_WAIT_L(0); PG8_BAR; PG8_MMA(1, 0, At, B0); PG8_MMA(1, 1, At, B1); PG8_BAR; PG8_SCHED;
            PG8_LDB(B0, 1, 0); PG8_LDB(B1, 1, 1); PG8_SCHED; PG8_LDA(At, 1, 0); PG8_STAGE(PG8_SA(0, 1), a2 + hstep, voffA);
            PG8_WAIT_V(8); PG8_WAIT_L(0); PG8_BAR; PG8_MMA(0, 0, At, B0); PG8_MMA(0, 1, At, B1); PG8_BAR; PG8_SCHED;
            PG8_LDA(At, 1, 1); PG8_STAGE(PG8_SB(1, 0), b3, voffB); PG8_STAGE(PG8_SB(1, 1), b3 + hstep, voffB); PG8_STAGE(PG8_SA(1, 0), a3, voffA);
            PG8_WAIT_V(8); PG8_WAIT_L(0); PG8_BAR; PG8_MMA(1, 0, At, B0); PG8_MMA(1, 1, At, B1); PG8_BAR; PG8_SCHED;
            } else {
            PG8_LDB(B0, 0, 0); PG8_SCHED; PG8_LDA(At, 0, 0); PG8_STAGE(PG8_SA(1, 1), a1 + hstep, voffA);
            PG8_WAIT_L(8); PG8_BAR; PG8_WAIT_L(0); PG8_MMA(0, 0, At, B0); PG8_BAR; PG8_SCHED;
            PG8_LDB(B1, 0, 1); PG8_STAGE(PG8_SB(0, 0), b2, voffB);
            PG8_BAR; PG8_WAIT_L(0); PG8_MMA(0, 1, At, B1); PG8_BAR;
            PG8_LDA(At, 0, 1); PG8_STAGE(PG8_SA(0, 0), a2, voffA);
            PG8_BAR; PG8_WAIT_L(0); PG8_MMA(1, 0, At, B0); PG8_BAR; PG8_SCHED;
            PG8_STAGE(PG8_SB(0, 1), b2 + hstep, voffB);
            PG8_WAIT_V(6); PG8_BAR; PG8_MMA(1, 1, At, B1); PG8_BAR;
            PG8_LDB(B0, 1, 0); PG8_SCHED; PG8_LDA(At, 1, 0); PG8_STAGE(PG8_SA(0, 1), a2 + hstep, voffA);
            PG8_WAIT_L(8); PG8_BAR; PG8_WAIT_L(0); PG8_MMA(0, 0, At, B0); PG8_BAR; PG8_SCHED;
            PG8_LDB(B1, 1, 1); PG8_STAGE(PG8_SB(1, 0), b3, voffB);
            PG8_BAR; PG8_WAIT_L(0); PG8_MMA(0, 1, At, B1); PG8_BAR;
            PG8_LDA(At, 1, 1); PG8_STAGE(PG8_SA(1, 0), a3, voffA);
            PG8_BAR; PG8_WAIT_L(0); PG8_MMA(1, 0, At, B0); PG8_BAR; PG8_SCHED;
            PG8_STAGE(PG8_SB(1, 1), b3 + hstep, voffB);
            PG8_WAIT_V(6); PG8_BAR; PG8_MMA(1, 1, At, B1); PG8_BAR;
            }
        }
        if constexpr (ALIGN_EPI) { if (wr == 0) PG8_BAR; }
        if constexpr (!Epi::AFTER_DRAIN) { E(acc, cur, wr, wc, fr, fq); S.done(cur); }
        if (!has_next) break;
#pragma unroll
        for (int a = 0; a < 2; ++a)
#pragma unroll
            for (int b = 0; b < 2; ++b)
#pragma unroll
                for (int m = 0; m < 4; ++m)
#pragma unroll
                    for (int n = 0; n < 2; ++n) acc[a][b][m][n] = (f32x4){0.f, 0.f, 0.f, 0.f};
        cur = nxt; cA = nA; cB = nB; ++ui;
        if constexpr (ALIGN_EPI) { if (wr == 1) PG8_BAR; }
    }
    PG8_WAIT_V(0);
    if constexpr (!ALIGN_EPI) { if (wr == 0) PG8_BAR; }
    PG8_BAR;
    if constexpr (Epi::AFTER_DRAIN) { E.fused(acc, cur, wr, wc, fr, fq, lds, wid, lane); S.done(cur); }
#undef PG8_SA
#undef PG8_SB
#undef PG8_STAGE
#undef PG8_LDA
#undef PG8_LDB
#undef PG8_MMA
#undef PG8_WAIT_V
#undef PG8_WAIT_L
#undef PG8_BAR
#undef PG8_SCHED
}
}
#define LAS __attribute__((address_space(3)))
typedef unsigned short bf16;
typedef unsigned u32x4 __attribute__((ext_vector_type(4)));
typedef float f32x4 __attribute__((ext_vector_type(4)));
typedef float f32x16 __attribute__((ext_vector_type(16)));
typedef short bf16x8 __attribute__((ext_vector_type(8)));
typedef short s16x4 __attribute__((ext_vector_type(4)));

constexpr int NB = 4, SEQ = 4096, DM = 1024, NMETA = 16, LTOT = SEQ + NMETA, NH = 16;
constexpr int MR = NB * SEQ;
constexpr int MP = MR + 256;
constexpr int N1 = 6400;
constexpr int NWT = 10496;
constexpr size_t PL = (size_t)MP * 1024 * 2;
constexpr size_t MiB = 1u << 20;
constexpr size_t WS_SSP = 0;
constexpr size_t WS_BONUS = 1 * MiB;
constexpr size_t WS_STAT = 2 * MiB;
constexpr size_t WS_PR = 10 * MiB;
constexpr size_t WS_LORA = WS_PR + 6 * PL;
constexpr size_t WS_XN = WS_LORA + (size_t)MP * 256 * 2;
constexpr size_t WS_END = WS_XN + PL;
static_assert(WS_END <= 256 * MiB, "ws map");
constexpr size_t DO_WTIN = 0;
constexpr size_t DO_WPR = DO_WTIN + (size_t)NWT * 1024 * 2;
constexpr size_t DO_WPS = DO_WPR + 2 * MiB;
constexpr size_t DO_WOUT = DO_WPS + 2 * MiB;
constexpr size_t DO_YR = DO_WOUT + 2 * MiB;
static_assert(DO_YR + (size_t)MR * 1024 * 2 <= (size_t)MR * 1024 * 4, "d_out map");
constexpr size_t WS_SEGS = 2 * MiB;
constexpr size_t WS_CTL = 8 * MiB, CTL_BYTES = 16384;
constexpr int LDS_XB = 147456 - 64;
constexpr size_t WCH = 3072 * 64 * 2;
constexpr size_t DO_WTAIL = DO_YR + (size_t)MR * 1024 * 2;
static_assert(33 * WCH <= (size_t)6400 * 2048 && WS_END + 27 * WCH <= 256 * MiB && DO_WTAIL + 4 * WCH <= (size_t)MR * 1024 * 4 && 64 * 3 * 2 * 16384 <= 8 * MiB, "W / SEGS map");
constexpr int SEG_C0 = 65;
constexpr int LDS_BYTES = 147456;
constexpr float QSCALE = 0.125f * 1.4426950408889634f;

__device__ __forceinline__ unsigned f2bf(float f) { unsigned u = __builtin_bit_cast(unsigned, f); return (u + 0x7fffu + ((u >> 16) & 1u)) >> 16; }
typedef float f32x2_t __attribute__((ext_vector_type(2))); typedef __bf16 bf16x2_t __attribute__((ext_vector_type(2)));
__device__ __forceinline__ unsigned pk2(float lo, float hi) { f32x2_t v = {lo, hi}; bf16x2_t b = __builtin_convertvector(v, bf16x2_t); return __builtin_bit_cast(unsigned, b); }
__device__ __forceinline__ unsigned short f2bfh(float f) { return (unsigned short)(pk2(f, 0.f) & 0xffffu); }
__device__ __forceinline__ float bflo(unsigned w) { return __uint_as_float(w << 16); }
__device__ __forceinline__ float bfhi(unsigned w) { return __uint_as_float(w & 0xffff0000u); }
__device__ __forceinline__ float wave_sum(float v) {
#pragma unroll
    for (int o = 1; o < 64; o <<= 1) v += __shfl_xor(v, o);
    return v;
}
#define LDS_WAIT() asm volatile("s_waitcnt lgkmcnt(0)" ::: "memory")

struct Args {
    const float *x, *meta, *pre_g, *post_g, *w_in, *mu, *w0, *w_up, *a0, *a_up, *k_k, *k_a, *r_k, *gn_g, *gn_b, *w_pr, *w_ps, *w_out;
    float* out; unsigned char* ws; int ph_lo, ph_hi;
};

__device__ __forceinline__ int wtin_src(int r0) {
    if (r0 < 3072) return r0;
    if (r0 < 6144) return 4224 + (r0 - 3072);
    if (r0 < 6272) return 3072 + (r0 - 6144);
    if (r0 < 6400) return -1;
    if (r0 < 7424) return 3200 + (r0 - 6400);
    if (r0 < 8448) return 7296 + (r0 - 7424);
    const int q = r0 - 8448, p = q >> 8, bj = (q >> 7) & 1, i = q & 127;
    return 8320 + 1024 * bj + 128 * p + i;
}
__device__ __forceinline__ void transpose_item(const float* W, int ldw, int srccol, int k0, bf16* WT, int drow, LAS float* scr, int lane) {
    float tv[32];
#pragma unroll
    for (int i = 0; i < 32; ++i) { const int kk = 2 * i + (lane >> 5); tv[i] = srccol >= 0 ? W[(size_t)(k0 + kk) * ldw + srccol + (lane & 31)] : 0.f; }
#pragma unroll
    for (int i = 0; i < 32; ++i) { const int kk = 2 * i + (lane >> 5); scr[kk * 33 + (lane & 31)] = tv[i]; }
    LDS_WAIT(); asm volatile("" ::: "memory");
    const int c = lane & 7;
#pragma unroll
    for (int j = 0; j < 4; ++j) { const int n = (lane >> 3) + 8 * j; const LAS float* s = scr + (8 * c) * 33 + n;
        u32x4 o; o.x = pk2(s[0 * 33], s[1 * 33]); o.y = pk2(s[2 * 33], s[3 * 33]); o.z = pk2(s[4 * 33], s[5 * 33]); o.w = pk2(s[6 * 33], s[7 * 33]);
        *(u32x4*)(WT + (size_t)(drow + n) * 1024 + k0 + 8 * c) = o; }
    LDS_WAIT(); asm volatile("" ::: "memory");
}
__device__ __forceinline__ void p0_prologue(const Args& A, LAS unsigned char* lds, const bool late, const int gw_l, const int ngw_l) {
    const int tid = threadIdx.x, lane = tid & 63, wave = tid >> 6;
    LAS float* scr = (LAS float*)(lds + wave * 16384);
    const int gw = blockIdx.x * 8 + wave, NGW = gridDim.x * 8;
    bf16* WTIN = (bf16*)((unsigned char*)A.out + DO_WTIN); bf16* WPR = (bf16*)((unsigned char*)A.out + DO_WPR); bf16* WPS = (bf16*)((unsigned char*)A.out + DO_WPS); bf16* WOUT = (bf16*)((unsigned char*)A.out + DO_WOUT);
    constexpr int I_IN = (NWT / 32) * 16, I_SQ = 32 * 16, I_EARLY = (N1 / 32) * 16;
    const int it_lo = late ? I_EARLY + gw_l : gw, it_hi = late ? I_IN + 3 * I_SQ : I_EARLY, it_st = late ? ngw_l : NGW;
    for (int it = it_lo; it < it_hi; it += it_st) {
        if (it < I_IN) { const int g = it >> 4, kb = it & 15; transpose_item(A.w_in, 10368, wtin_src(32 * g), 64 * kb, WTIN, 32 * g, scr, lane); }
        else { const int r = it - I_IN, w = r / I_SQ, q = r % I_SQ, g = q >> 4, kb = q & 15;
            transpose_item(w == 0 ? A.w_pr : (w == 1 ? A.w_ps : A.w_out), 1024, 32 * g, 64 * kb, w == 0 ? WPR : (w == 1 ? WPS : WOUT), 32 * g, scr, lane); }
    }
    if (late) return;
    bf16* XN = (bf16*)(A.ws + WS_XN);
    for (int m0 = gw; m0 < MP; m0 += 2 * NGW) {
        f32x4 v[2][4]; float s[2] = {0.f, 0.f};
#pragma unroll
        for (int u = 0; u < 2; ++u) { const int m = m0 + u * NGW;
            if (m < MR + NMETA) { const float* src = (m < MR) ? A.x + (size_t)m * 1024 : A.meta + (size_t)(m - MR) * 1024; const f32x4* xr = (const f32x4*)src + lane;
#pragma unroll
                for (int j = 0; j < 4; ++j) v[u][j] = __builtin_nontemporal_load(xr + 64 * j); }
            else {
#pragma unroll
                for (int j = 0; j < 4; ++j) v[u][j] = (f32x4){0.f, 0.f, 0.f, 0.f}; } }
#pragma unroll
        for (int u = 0; u < 2; ++u)
#pragma unroll
            for (int j = 0; j < 4; ++j) s[u] += (v[u][j].x * v[u][j].x + v[u][j].y * v[u][j].y) + (v[u][j].z * v[u][j].z + v[u][j].w * v[u][j].w);
#pragma unroll
        for (int u = 0; u < 2; ++u) { const int m = m0 + u * NGW; if (m < MP) {
            const float inv = __builtin_amdgcn_rsqf(wave_sum(s[u]) * (1.f / 1024.f) + 1e-6f);
            unsigned long long* o8 = (unsigned long long*)(XN + (size_t)m * 1024) + lane; const f32x4* gr = (const f32x4*)A.pre_g + lane;
#pragma unroll
            for (int j = 0; j < 4; ++j) { const f32x4 g = gr[64 * j]; o8[64 * j] = (unsigned long long)pk2(v[u][j].x * inv * g.x, v[u][j].y * inv * g.y) | ((unsigned long long)pk2(v[u][j].z * inv * g.z, v[u][j].w * inv * g.w) << 32); } } }
    }
}

constexpr int CS = 16, NCHK = LTOT / CS;
typedef short s16x4v __attribute__((ext_vector_type(4)));
__device__ __forceinline__ int tok_row(int b, int t) { return t < NMETA ? MR + t : b * SEQ + t - NMETA; }
__device__ __forceinline__ float dpp_sum16(float x) {
    x += __builtin_bit_cast(float, __builtin_amdgcn_update_dpp(0, __builtin_bit_cast(int, x), 0xB1, 0xF, 0xF, true));
    x += __builtin_bit_cast(float, __builtin_amdgcn_update_dpp(0, __builtin_bit_cast(int, x), 0x4E, 0xF, 0xF, true));
    x += __builtin_bit_cast(float, __builtin_amdgcn_update_dpp(0, __builtin_bit_cast(int, x), 0x141, 0xF, 0xF, true));
    x += __builtin_bit_cast(float, __builtin_amdgcn_update_dpp(0, __builtin_bit_cast(int, x), 0x140, 0xF, 0xF, true));
    return x;
}
__device__ __forceinline__ float wave_sum64(float x) { const float s = dpp_sum16(x); const int si = __builtin_bit_cast(int, s);
    return (__builtin_bit_cast(float, __builtin_amdgcn_readlane(si, 0)) + __builtin_bit_cast(float, __builtin_amdgcn_readlane(si, 16))) + (__builtin_bit_cast(float, __builtin_amdgcn_readlane(si, 32)) + __builtin_bit_cast(float, __builtin_amdgcn_readlane(si, 48))); }
__device__ __forceinline__ s16x4v cvt4(const f32x4 v) { typedef unsigned u32x2_t __attribute__((ext_vector_type(2))); u32x2_t w; w[0] = pk2(v[0], v[1]); w[1] = pk2(v[2], v[3]); return __builtin_bit_cast(s16x4v, w); }
constexpr int SC_SH = 0;
constexpr int SC_LOGD = SC_SH + 20480;
constexpr int SC_AA = SC_LOGD + 4096;
constexpr int SC_KKU = SC_AA + 4096;
constexpr int SC_KP = SC_KKU + 4096;
constexpr int SC_CUM = SC_KP + 4096;
constexpr int SC_SSQ = SC_CUM + 4352;
constexpr int SC_BNP = SC_SSQ + 256;
constexpr int SC_AF = SC_BNP + 256;
constexpr int SC_YOUT = SC_AF + 1024;
constexpr int SC_WOUT = SC_YOUT + 4096;
constexpr int SC_CST = SC_WOUT + 4096;
constexpr int SC_SET = SC_CST + 3072;
constexpr int TMS = 72;
constexpr int ST_AL = 0, ST_RB = 2304, ST_BTM = 4608, ST_KTM = 6912, ST_BT = 9216, ST_KT = 11264, ST_VT = 13312;
constexpr int ST_TT = 15360, ST_BB = 15872, ST_A2 = 16384, ST_B2 = 16896, ST_PC = 17408, ST_BON = 17664, ST_SIZE = 17792;
static_assert(SC_SET + 2 * ST_SIZE <= LDS_BYTES, "scan LDS");

#define LBAR() do { asm volatile("s_waitcnt lgkmcnt(0)" ::: "memory"); __builtin_amdgcn_s_barrier(); asm volatile("" ::: "memory"); } while (0)
__device__ __forceinline__ void scan_chain(const Args& A, LAS unsigned char* lds, const int chain, const int seg) {
    const int c_lo = seg ? SEG_C0 + 64 * (seg - 1) : 0, c_hi = SEG_C0 + 64 * seg;
    const int tid = threadIdx.x, lane = tid & 63, wid = __builtin_amdgcn_readfirstlane(tid >> 6), l15 = lane & 15, q = lane >> 4;
    const int b = chain >> 4, h = chain & 15;
    LAS float* SH = (LAS float*)(lds + SC_SH); LAS float* LOGD = (LAS float*)(lds + SC_LOGD); LAS float* AA = (LAS float*)(lds + SC_AA); LAS float* KKU = (LAS float*)(lds + SC_KKU);
    LAS float* KP = (LAS float*)(lds + SC_KP); LAS float* CUM = (LAS float*)(lds + SC_CUM); LAS float* SSQ = (LAS float*)(lds + SC_SSQ); LAS float* BNP = (LAS float*)(lds + SC_BNP);
    LAS float* AF = (LAS float*)(lds + SC_AF); LAS float* YOUT = (LAS float*)(lds + SC_YOUT); LAS float* WOUT = (LAS float*)(lds + SC_WOUT); LAS float* CST = (LAS float*)(lds + SC_CST);
    const bf16* PR = (const bf16*)(A.ws + WS_PR); const bf16* PK = (const bf16*)(A.ws + WS_PR + PL); const bf16* PV = (const bf16*)(A.ws + WS_PR + 2 * PL);
    const bf16* LORA = (const bf16*)(A.ws + WS_LORA);
    bf16* YR = (bf16*)((unsigned char*)A.out + DO_YR); float* BONUS = (float*)(A.ws + WS_BONUS);
    bf16* Wc = (bf16*)(chain < 33 ? (unsigned char*)A.out + (size_t)chain * WCH : (chain < 60 ? A.ws + WS_END + (size_t)(chain - 33) * WCH : (unsigned char*)A.out + DO_WTAIL + (size_t)(chain - 60) * WCH));
    __syncthreads();
    for (int i = tid; i < 768; i += 512) { const int a = i >> 6, j = i & 63; float v;
        if (a < 3) v = A.mu[a * 1024 + h * 64 + j]; else if (a == 3) v = A.mu[3072 + j]; else if (a == 4) v = A.mu[3136 + j];
        else if (a == 5) v = A.w0[h * 64 + j]; else if (a == 6) v = A.a0[h * 64 + j]; else if (a == 7) v = A.k_k[h * 64 + j]; else if (a == 8) v = A.k_a[h * 64 + j];
        else if (a == 9) v = A.r_k[h * 64 + j]; else if (a == 10) v = A.gn_g[h * 64 + j]; else v = A.gn_b[h * 64 + j];
        CST[i] = v; }
    const int ct = wid & 3;
    bf16x8 bw[2], ba[2];
#pragma unroll
    for (int ks = 0; ks < 2; ++ks)
#pragma unroll
        for (int j = 0; j < 8; ++j) { const int k = 32 * ks + 8 * q + j; const size_t o = (size_t)k * 1024 + h * 64 + 16 * ct + l15;
            bw[ks][j] = (short)f2bf(A.w_up[o]); ba[ks][j] = (short)f2bf(A.a_up[o]); }
    f32x4 sT[4];
#pragma unroll
    for (int m = 0; m < 4; ++m) sT[m] = (f32x4){0.f, 0.f, 0.f, 0.f};
    f32x4 sI[4];
#pragma unroll
    for (int m = 0; m < 4; ++m)
#pragma unroll
        for (int r = 0; r < 4; ++r) sI[m][r] = (16 * m + 4 * q + r == 16 * wid + l15) ? 1.f : 0.f;
    u32x4 pc[2], pp[2];
#define SCAN_ITEMS(I0, I1) const int I0 = (wid < 4) ? tid : ((wid >= 5) ? 448 + (tid - 320) : 0), I1 = (wid < 3) ? tid + 256 : I0
#define SCAN_ISSUE(c0) do { SCAN_ITEMS(i0_, i1_); _Pragma("unroll") for (int qq = 0; qq < 2; ++qq) { const int it = qq ? i1_ : i0_; \
        const int arr = it / (CS * 8), rem = it % (CS * 8), t = rem >> 3, cg = rem & 7; const int tg = (c0) * CS + t; \
        const int rc = tok_row(b, tg), rp = tok_row(b, tg > 0 ? tg - 1 : 0); \
        const bf16* bs = arr == 0 ? PR : (arr == 1 ? PK : (arr == 2 ? PV : LORA)); const int ld = arr < 3 ? 1024 : 256; const int co = arr < 3 ? h * 64 + 8 * cg : (arr == 3 ? 8 * cg : 64 + 8 * cg); \
        pc[qq] = *(const u32x4*)(bs + (size_t)rc * ld + co); pp[qq] = *(const u32x4*)(bs + (size_t)rp * ld + co); } } while (0)
#define SCAN_SHIFT(cc) do { SCAN_ITEMS(i0_, i1_); _Pragma("unroll") for (int qq = 0; qq < 2; ++qq) if (qq == 0 || wid < 3) { const int it = qq ? i1_ : i0_; \
        const int arr = it / (CS * 8), rem = it % (CS * 8), t = rem >> 3, cg = rem & 7; const int tg = (cc) * CS + t; \
        const u32x4 cu = pc[qq]; u32x4 pv = pp[qq]; if (tg == 0) pv = (u32x4){0u, 0u, 0u, 0u}; \
        const float fc[8] = {bflo(cu.x), bfhi(cu.x), bflo(cu.y), bfhi(cu.y), bflo(cu.z), bfhi(cu.z), bflo(cu.w), bfhi(cu.w)}; \
        const float fp[8] = {bflo(pv.x), bfhi(pv.x), bflo(pv.y), bfhi(pv.y), bflo(pv.z), bfhi(pv.z), bflo(pv.w), bfhi(pv.w)}; \
        LAS float* dst = SH + (arr * CS + t) * 64 + 8 * cg; const LAS float* mu = CST + arr * 64 + 8 * cg; \
        float sv_[8]; \
        _Pragma("unroll") for (int i = 0; i < 8; ++i) { float v = fc[i] + (fp[i] - fc[i]) * mu[i]; \
            if (arr == 3) { const float e = __builtin_amdgcn_exp2f(2.885390081777927f * v); v = 1.0f - 2.0f * __builtin_amdgcn_rcpf(1.0f + e); } \
            sv_[i] = v; } \
        if (arr < 3) { *(LAS f32x4*)dst = (f32x4){sv_[0], sv_[1], sv_[2], sv_[3]}; *(LAS f32x4*)(dst + 4) = (f32x4){sv_[4], sv_[5], sv_[6], sv_[7]}; } \
        else { *(LAS u32x4*)((LAS bf16*)(SH + 3 * CS * 64) + ((arr - 3) * CS + t) * TMS + 8 * cg) = (u32x4){pk2(sv_[0], sv_[1]), pk2(sv_[2], sv_[3]), pk2(sv_[4], sv_[5]), pk2(sv_[6], sv_[7])}; } } } while (0)
    SCAN_ISSUE(c_lo);
    __syncthreads();
    if (wid != 4) SCAN_SHIFT(c_lo);
    SCAN_ISSUE(c_lo + 1);
    __syncthreads();
#define SCAN_EPI() do { if (c >= 2) { \
        _Pragma("unroll") for (int i = 0; i < 4; ++i) { const int t = 4 * wid + i; const int tg = (c - 1) * CS + t; const size_t row = (size_t)(b * SEQ + tg - NMETA); \
            YR[row * 1024 + h * 64 + lane] = f2bfh(YOUT[t * 64 + lane]); \
            if (seg) Wc[(size_t)(tg - SEG_C0 * CS) * 64 + lane] = f2bfh(WOUT[t * 64 + lane]); \
            if (lane == 0) BONUS[row * 16 + h] = ((const LAS float*)(setc + ST_BON))[t]; } } } while (0)
    for (int c = c_lo; c <= c_hi; ++c) {
        const bool prod = c < c_hi, cons = c > c_lo;
        LAS unsigned char* setp = lds + SC_SET + (c & 1) * ST_SIZE;
        LAS unsigned char* setc = lds + SC_SET + ((c - 1) & 1) * ST_SIZE;
        if (wid < 4) {
            if (cons) {
                const int row = 16 * wid + l15;
                bf16x8 sb0, sb1;
#pragma unroll
                for (int r = 0; r < 4; ++r) { sb0[r] = cvt4(sT[0])[r]; sb0[4 + r] = cvt4(sT[1])[r]; sb1[r] = cvt4(sT[2])[r]; sb1[4 + r] = cvt4(sT[3])[r]; }
                const LAS bf16* ALr = (const LAS bf16*)(setc + ST_AL) + l15 * TMS; const LAS bf16* RBr = (const LAS bf16*)(setc + ST_RB) + l15 * TMS;
                bf16x8 al0, al1, rb0, rb1;
                { const s16x4v a = *(const LAS s16x4v*)(ALr + 4 * q), b2 = *(const LAS s16x4v*)(ALr + 16 + 4 * q), c2 = *(const LAS s16x4v*)(ALr + 32 + 4 * q), d2 = *(const LAS s16x4v*)(ALr + 48 + 4 * q);
                  al0 = (bf16x8){a[0], a[1], a[2], a[3], b2[0], b2[1], b2[2], b2[3]}; al1 = (bf16x8){c2[0], c2[1], c2[2], c2[3], d2[0], d2[1], d2[2], d2[3]}; }
                { const s16x4v a = *(const LAS s16x4v*)(RBr + 4 * q), b2 = *(const LAS s16x4v*)(RBr + 16 + 4 * q), c2 = *(const LAS s16x4v*)(RBr + 32 + 4 * q), d2 = *(const LAS s16x4v*)(RBr + 48 + 4 * q);
                  rb0 = (bf16x8){a[0], a[1], a[2], a[3], b2[0], b2[1], b2[2], b2[3]}; rb1 = (bf16x8){c2[0], c2[1], c2[2], c2[3], d2[0], d2[1], d2[2], d2[3]}; }
                const s16x4v bb = *(const LAS s16x4v*)((const LAS bf16*)(setc + ST_BB) + l15 * 16 + 4 * q), tt = *(const LAS s16x4v*)((const LAS bf16*)(setc + ST_TT) + l15 * 16 + 4 * q);
                const s16x4v a2 = *(const LAS s16x4v*)((const LAS bf16*)(setc + ST_A2) + l15 * 16 + 4 * q), b2v = *(const LAS s16x4v*)((const LAS bf16*)(setc + ST_B2) + l15 * 16 + 4 * q);
                const int qs = 4 * (q ^ ((l15 >> 2) & 3));
                const s16x4v vt = *(const LAS s16x4v*)((const LAS bf16*)(setc + ST_VT) + row * 16 + qs);
                const f32x4 z4 = {0.f, 0.f, 0.f, 0.f};
                f32x4 rhs = __builtin_amdgcn_mfma_f32_16x16x32_bf16(al0, sb0, z4, 0, 0, 0);
                rhs = __builtin_amdgcn_mfma_f32_16x16x32_bf16(al1, sb1, rhs, 0, 0, 0);
                rhs = __builtin_amdgcn_mfma_f32_16x16x16bf16_1k(bb, vt, rhs, 0, 0, 0);
                f32x4 y = __builtin_amdgcn_mfma_f32_16x16x32_bf16(rb0, sb0, z4, 0, 0, 0);
                y = __builtin_amdgcn_mfma_f32_16x16x32_bf16(rb1, sb1, y, 0, 0, 0);
                y = __builtin_amdgcn_mfma_f32_16x16x16bf16_1k(b2v, vt, y, 0, 0, 0);
                const f32x4 u = __builtin_amdgcn_mfma_f32_16x16x16bf16_1k(tt, cvt4(rhs), z4, 0, 0, 0);
                const s16x4v ub = cvt4(u);
                y = __builtin_amdgcn_mfma_f32_16x16x16bf16_1k(a2, ub, y, 0, 0, 0);
#pragma unroll
                for (int r = 0; r < 4; ++r) YOUT[(4 * q + r) * 64 + row] = y[r];
                bf16x8 ib0, ib1;
                { const s16x4v c0 = cvt4(sI[0]), c1 = cvt4(sI[1]), c2 = cvt4(sI[2]), c3 = cvt4(sI[3]);
                  ib0 = (bf16x8){c0[0], c0[1], c0[2], c0[3], c1[0], c1[1], c1[2], c1[3]}; ib1 = (bf16x8){c2[0], c2[1], c2[2], c2[3], c3[0], c3[1], c3[2], c3[3]}; }
                f32x4 rhsI = __builtin_amdgcn_mfma_f32_16x16x32_bf16(al0, ib0, z4, 0, 0, 0);
                rhsI = __builtin_amdgcn_mfma_f32_16x16x32_bf16(al1, ib1, rhsI, 0, 0, 0);
                f32x4 yI = __builtin_amdgcn_mfma_f32_16x16x32_bf16(rb0, ib0, z4, 0, 0, 0);
                yI = __builtin_amdgcn_mfma_f32_16x16x32_bf16(rb1, ib1, yI, 0, 0, 0);
                const f32x4 uI = __builtin_amdgcn_mfma_f32_16x16x16bf16_1k(tt, cvt4(rhsI), z4, 0, 0, 0);
                const s16x4v ubI = cvt4(uI);
                yI = __builtin_amdgcn_mfma_f32_16x16x16bf16_1k(a2, ubI, yI, 0, 0, 0);
#pragma unroll
                for (int r = 0; r < 4; ++r) WOUT[(4 * q + r) * 64 + row] = yI[r];
#pragma unroll
                for (int m = 0; m < 4; ++m) {
                    const s16x4v btm = *(const LAS s16x4v*)((const LAS bf16*)(setc + ST_BT) + (16 * m + l15) * 16 + qs), ktm = *(const LAS s16x4v*)((const LAS bf16*)(setc + ST_KT) + (16 * m + l15) * 16 + qs);
                    f32x4 s = __builtin_amdgcn_mfma_f32_16x16x16bf16_1k(btm, ub, sT[m], 0, 0, 0);
                    s = __builtin_amdgcn_mfma_f32_16x16x16bf16_1k(ktm, vt, s, 0, 0, 0);
                    const f32x4 pcv = *(const LAS f32x4*)((const LAS float*)(setc + ST_PC) + 16 * m + 4 * q);
                    sT[m] = s * pcv;
                    sI[m] = __builtin_amdgcn_mfma_f32_16x16x16bf16_1k(btm, ubI, sI[m], 0, 0, 0) * pcv;
                }
            }
        } else if (prod) {
            const int ct = wid - 4;
            f32x4 aw = {0.f, 0.f, 0.f, 0.f}, aa = {0.f, 0.f, 0.f, 0.f};
#pragma unroll
            for (int ks = 0; ks < 2; ++ks) {
                const LAS bf16* lw = (const LAS bf16*)(SH + 3 * CS * 64) + l15 * TMS + 32 * ks + 8 * q;
                const bf16x8 fw = *(const LAS bf16x8*)lw, fa = *(const LAS bf16x8*)(lw + CS * TMS);
                aw = __builtin_amdgcn_mfma_f32_16x16x32_bf16(fw, bw[ks], aw, 0, 0, 0);
                aa = __builtin_amdgcn_mfma_f32_16x16x32_bf16(fa, ba[ks], aa, 0, 0, 0);
            }
            const int j = 16 * ct + l15;
            const float w0j = CST[5 * 64 + j], a0j = CST[6 * 64 + j], kkj = CST[7 * 64 + j], kaj = CST[8 * 64 + j], rkj = CST[9 * 64 + j];
            float lg[4];
#pragma unroll
            for (int r = 0; r < 4; ++r) {
                const int t = 4 * q + r;
                const float sgw = __builtin_amdgcn_rcpf(1.0f + __builtin_amdgcn_exp2f(-1.4426950408889634f * (w0j + aw[r])));
                const float a = __builtin_amdgcn_rcpf(1.0f + __builtin_amdgcn_exp2f(-1.4426950408889634f * (a0j + aa[r])));
                const float ksh = SH[(1 * CS + t) * 64 + j], rsh = SH[(0 * CS + t) * 64 + j];
                const float kku = ksh * kkj, kp = ksh * (1.0f + (a - 1.0f) * kaj);
                lg[r] = -0.6065306597126334f * 1.4426950408889634f * sgw; AA[t * 64 + j] = a; KKU[t * 64 + j] = kku; KP[t * 64 + j] = kp;
            }
            { const float cp1 = lg[0], cp2 = cp1 + lg[1], cp3 = cp2 + lg[2], cp4 = cp3 + lg[3];
              LAS float* XQ = SSQ + ct * 64;
              XQ[lane] = cp4; asm volatile("s_waitcnt lgkmcnt(0)" ::: "memory");
              const float g0 = XQ[l15], g1 = XQ[l15 + 16], g2 = XQ[l15 + 32];
              const float off = (q > 0 ? g0 : 0.f) + (q > 1 ? g1 : 0.f) + (q > 2 ? g2 : 0.f);
              const float cpr[5] = {off, off + cp1, off + cp2, off + cp3, off + cp4};
#pragma unroll
              for (int r = 0; r < 4; ++r) { CUM[(4 * q + r) * 64 + j] = cpr[r]; LOGD[(4 * q + r) * 64 + j] = cpr[r + 1]; } }
        }
        LBAR();
        if (!prod) {
            if (wid < 4) { SCAN_EPI(); }
            LBAR();
            break;
        }
        { const int t0 = tid >> 6, k = tid & 63;
#pragma unroll
          for (int i = 0; i < 2; ++i) { const int t = t0 + 8 * i, e = t * 64 + k;
            const float kku_ = KKU[e], rsh_ = SH[(0 * CS + t) * 64 + k];
            const float rs = __builtin_amdgcn_rsqf(wave_sum64(kku_ * kku_) + 1e-12f), bon_ = wave_sum64(rsh_ * KP[e] * CST[9 * 64 + k]);
            const float c0 = CUM[e], c1 = LOGD[e];
            const float e0 = __builtin_amdgcn_exp2f(c0), e1 = __builtin_amdgcn_exp2f(c1), ie1 = __builtin_amdgcn_exp2f(-c1);
            const float kk = kku_ * rs;
            const unsigned w01 = pk2(kk * e0, rsh_ * e1), w23 = pk2(-kk * AA[e] * ie1, KP[e] * ie1); const bf16 al = (bf16)(w01 & 0xffffu), rb = (bf16)(w01 >> 16), bt = (bf16)(w23 & 0xffffu), kt = (bf16)(w23 >> 16);
            { const int et = t * TMS + k; ((LAS bf16*)(setp + ST_AL))[et] = al; ((LAS bf16*)(setp + ST_RB))[et] = rb; ((LAS bf16*)(setp + ST_BTM))[et] = bt; ((LAS bf16*)(setp + ST_KTM))[et] = kt; }
            const int tsw = 4 * ((t >> 2) ^ ((k >> 2) & 3)) + (t & 3);
            ((LAS bf16*)(setp + ST_BT))[k * 16 + tsw] = bt; ((LAS bf16*)(setp + ST_KT))[k * 16 + tsw] = kt;
            ((LAS bf16*)(setp + ST_VT))[k * 16 + tsw] = f2bfh(SH[(2 * CS + t) * 64 + k]);
            if (t == CS - 1) ((LAS float*)(setp + ST_PC))[k] = e1;
            if (k == 0) ((LAS float*)(setp + ST_BON))[t] = bon_; } }
        LBAR();
        if (wid >= 4) { const int p = wid - 4;
            const LAS bf16* ALr = (const LAS bf16*)(setp + ST_AL) + l15 * TMS; const LAS bf16* RBr = (const LAS bf16*)(setp + ST_RB) + l15 * TMS;
            const LAS bf16* BTr = (const LAS bf16*)(setp + ST_BTM) + l15 * TMS; const LAS bf16* KTr = (const LAS bf16*)(setp + ST_KTM) + l15 * TMS;
            const f32x4 z4 = {0.f, 0.f, 0.f, 0.f};
            if (p == 0) {
                f32x4 xt = z4, xa = z4;
#pragma unroll
                for (int ks = 0; ks < 2; ++ks) { const bf16x8 a = *(const LAS bf16x8*)(ALr + 32 * ks + 8 * q), bq = *(const LAS bf16x8*)(BTr + 32 * ks + 8 * q);
                    xt = __builtin_amdgcn_mfma_f32_16x16x32_bf16(a, bq, xt, 0, 0, 0); xa = __builtin_amdgcn_mfma_f32_16x16x32_bf16(bq, a, xa, 0, 0, 0); }
                f32x4 idn;
#pragma unroll
                for (int r = 0; r < 4; ++r) { const int rr = 4 * q + r; xt[r] = (l15 < rr) ? xt[r] : 0.f; xa[r] = (rr < l15) ? xa[r] : 0.f; idn[r] = (rr == l15) ? 1.f : 0.f; }
                s16x4v X = cvt4(xa), XT = cvt4(xt);
                f32x4 Tm = xa + idn, TmT = xt + idn;
                f32x4 x2 = __builtin_amdgcn_mfma_f32_16x16x16bf16_1k(XT, X, z4, 0, 0, 0), x2t = __builtin_amdgcn_mfma_f32_16x16x16bf16_1k(X, XT, z4, 0, 0, 0);
                s16x4v X2 = cvt4(x2), X2T = cvt4(x2t);
                { const s16x4v t1 = cvt4(Tm), t1t = cvt4(TmT);
                  Tm = __builtin_amdgcn_mfma_f32_16x16x16bf16_1k(t1t, X2, Tm, 0, 0, 0); TmT = __builtin_amdgcn_mfma_f32_16x16x16bf16_1k(X2, t1t, TmT, 0, 0, 0); }
                f32x4 x4 = __builtin_amdgcn_mfma_f32_16x16x16bf16_1k(X2T, X2, z4, 0, 0, 0), x4t = __builtin_amdgcn_mfma_f32_16x16x16bf16_1k(X2, X2T, z4, 0, 0, 0);
                s16x4v X4 = cvt4(x4), X4T = cvt4(x4t);
                { const s16x4v t2t = cvt4(TmT);
                  Tm = __builtin_amdgcn_mfma_f32_16x16x16bf16_1k(t2t, X4, Tm, 0, 0, 0); TmT = __builtin_amdgcn_mfma_f32_16x16x16bf16_1k(X4, t2t, TmT, 0, 0, 0); }
                const f32x4 x8 = __builtin_amdgcn_mfma_f32_16x16x16bf16_1k(X4T, X4, z4, 0, 0, 0);
                { const s16x4v t4t = cvt4(TmT), X8 = cvt4(x8);
                  Tm = __builtin_amdgcn_mfma_f32_16x16x16bf16_1k(t4t, X8, Tm, 0, 0, 0); }
                *(LAS s16x4v*)((LAS bf16*)(setp + ST_TT) + l15 * 16 + 4 * q) = cvt4(Tm);
            } else {
                const LAS bf16* Lm = (p == 1) ? ALr : RBr; const LAS bf16* Rm = (p == 2) ? BTr : KTr;
                f32x4 x = z4;
#pragma unroll
                for (int ks = 0; ks < 2; ++ks) x = __builtin_amdgcn_mfma_f32_16x16x32_bf16(*(const LAS bf16x8*)(Lm + 32 * ks + 8 * q), *(const LAS bf16x8*)(Rm + 32 * ks + 8 * q), x, 0, 0, 0);
#pragma unroll
                for (int r = 0; r < 4; ++r) { const int t = 4 * q + r; const bool keep = (p == 1) ? (l15 < t) : (l15 <= t);
                    ((LAS bf16*)(setp + (p == 1 ? ST_BB : (p == 2 ? ST_A2 : ST_B2))))[t * 16 + l15] = f2bfh(keep ? x[r] : 0.f); }
            }
        }
        if (wid < 4 && cons) { SCAN_EPI(); }
        if (wid != 4 && c + 1 < c_hi) SCAN_SHIFT(c + 1);
        { const int cn = c + 2 < c_hi ? c + 2 : c_hi - 1; SCAN_ISSUE(cn); }
        LBAR();
    }
#undef SCAN_SHIFT
#undef SCAN_ITEMS
#undef SCAN_EPI
#undef SCAN_ISSUE
    if (wid < 4 && seg < 3) { float* sg = (float*)(A.ws + WS_SEGS) + (size_t)((chain * 3 + seg) * 2) * 4096 + (16 * wid + l15) * 64 + 4 * q;
#pragma unroll
        for (int m = 0; m < 4; ++m) { *(f32x4*)(sg + 16 * m) = sT[m]; *(f32x4*)(sg + 4096 + 16 * m) = sI[m]; } }
}

__device__ __forceinline__ int crow(int r, int hi) { return (r & 3) + 8 * (r >> 2) + 4 * hi; }
__device__ __forceinline__ int slot_key(int i) { const int i5 = i & 31; return (i & 32) + 16 * ((i5 >> 2) & 1) + (i5 & 3) + 4 * (i5 >> 3); }
constexpr int AT_K = 0, AT_V = 8192, AT_FLAG = 16384;
__device__ __forceinline__ void attn_phase(const Args& A, LAS unsigned char* lds) {
    const int tid = threadIdx.x, lane = tid & 63, r32 = lane & 31, hi = lane >> 5, wid = __builtin_amdgcn_readfirstlane(tid >> 6);
    bf16* Q = (bf16*)(A.ws + WS_PR + 3 * PL); const bf16* K = (const bf16*)(A.ws + WS_PR + 4 * PL); const bf16* V = (const bf16*)(A.ws + WS_PR + 5 * PL);
    LAS float* FLAG = (LAS float*)(lds + AT_FLAG);
    const int vb = (int)(unsigned)(uintptr_t)(lds + AT_V) + ((lane >> 4) & 1) * 32 + (lane & 3) * 8 + (4 * hi + ((lane & 15) >> 2)) * 64;
    const int kslot = slot_key(lane);
    const int vslot = slot_key(16 * (wid & 3) + (lane >> 2));
    unsigned* qctr = (unsigned*)(A.ws + WS_CTL) + 4000;
    LAS int* UQ = (LAS int*)(lds + AT_FLAG + 64);
    for (;;) {
        __syncthreads();
        if (tid == 0) *UQ = (int)atomicAdd(qctr, 1u);
        __syncthreads();
        const int unit = *UQ; if (unit >= NB * NH * 16) break;
        const int bh = unit & 63, qb = 15 - (unit >> 6), b = bh >> 4, h = bh & 15;
        const int tq0 = NMETA + 256 * qb, tqw = tq0 + 32 * wid;
        const int uqw = 256 * qb + 32 * wid, uq = uqw + r32;
        const bf16* Qw = Q + (size_t)(b * SEQ + tqw - NMETA) * 1024 + h * 64;
        bf16x8 qr[4];
#pragma unroll
        for (int d0 = 0; d0 < 4; ++d0) qr[d0] = *(const bf16x8*)(Qw + (size_t)r32 * 1024 + d0 * 16 + hi * 8);
        f32x16 o0 = {}, o1 = {}; float c = 1.f;
        float wcm = 1.f;
        const int jmax = 4 * qb + 3;
        u32x4 kreg, vreg;
#define AT_LOAD(j) do { const size_t rk_ = (j) >= 0 ? (size_t)(b * SEQ + 64 * (j) + kslot) : (size_t)(MR + (kslot < NMETA ? kslot : NMETA - 1)), rv_ = (j) >= 0 ? (size_t)(b * SEQ + 64 * (j) + vslot) : (size_t)(MR + (vslot < NMETA ? vslot : NMETA - 1)); \
            kreg = *(const u32x4*)(K + rk_ * 1024 + h * 64 + 8 * wid); vreg = *(const u32x4*)(V + rv_ * 1024 + h * 64 + (wid >> 2) * 32 + (lane & 3) * 8); } while (0)
        AT_LOAD(jmax);
        if (lane == 0) FLAG[wid] = 1.f;
        for (int j = jmax; j >= -1; --j) {
            __syncthreads();
            { float fm = FLAG[0];
#pragma unroll
              for (int i = 1; i < 8; ++i) fm = fmaxf(fm, FLAG[i]);
              if (fm < 1.17549435e-38f) break; }
            *(LAS u32x4*)(lds + AT_K + wid * 1024 + lane * 16) = kreg; *(LAS u32x4*)(lds + AT_V + wid * 1024 + lane * 16) = vreg;
            { const int jn = j > -1 ? j - 1 : -1; AT_LOAD(jn); }
            __syncthreads();
            if (64 * j > uqw + 31) continue;
            if (wcm < 1.17549435e-38f) continue;
            f32x16 p0 = {}, p1 = {};
            { const LAS unsigned char* kb = lds + AT_K + hi * 1024 + r32 * 16;
#pragma unroll
              for (int d0 = 0; d0 < 4; ++d0) { const bf16x8 b0 = *(const LAS bf16x8*)(kb + d0 * 2048), b1 = *(const LAS bf16x8*)(kb + d0 * 2048 + 512);
                  p0 = __builtin_amdgcn_mfma_f32_32x32x16_bf16(b0, qr[d0], p0, 0, 0, 0); p1 = __builtin_amdgcn_mfma_f32_32x32x16_bf16(b1, qr[d0], p1, 0, 0, 0); } }
            const int kbase = (j >= 0 ? 64 * j : 0) + 16 * hi, tq = j >= 0 ? uq : NMETA;
            float T0 = 1.f, T1 = 1.f;
#define AT_ELEM(MASKED) do { \
            _Pragma("unroll") for (int r = 15; r >= 0; --r) { const float e = __builtin_amdgcn_exp2f(fminf(p1[r], 100.f)); float kp = __builtin_amdgcn_rcpf(1.0f + e), be = e * kp; \
                if (MASKED) { if (kbase + 32 + r >= tq) { kp = 1.f; be = 0.f; } } p1[r] = be * T1; T1 *= kp; } \
            _Pragma("unroll") for (int r = 15; r >= 0; --r) { const float e = __builtin_amdgcn_exp2f(fminf(p0[r], 100.f)); float kp = __builtin_amdgcn_rcpf(1.0f + e), be = e * kp; \
                if (MASKED) { if (kbase + r >= tq) { kp = 1.f; be = 0.f; } } p0[r] = be * T0; T0 *= kp; } } while (0)
            if (j < 0 || 64 * j + 63 >= uqw) AT_ELEM(1); else AT_ELEM(0);
#undef AT_ELEM
            float PT0, PT1;
            { auto r0 = __builtin_amdgcn_permlane32_swap(__float_as_uint(T0), __float_as_uint(T0), false, false); PT0 = __uint_as_float(hi ? r0[0] : r0[1]);
              auto r1 = __builtin_amdgcn_permlane32_swap(__float_as_uint(T1), __float_as_uint(T1), false, false); PT1 = __uint_as_float(hi ? r1[0] : r1[1]); }
            const float off0 = c * (hi ? (T1 * PT1) : (PT0 * T1 * PT1)), off1 = c * (hi ? 1.f : PT1);
#pragma unroll
            for (int r = 0; r < 16; ++r) { p0[r] *= off0; p1[r] *= off1; }
            c *= (T0 * T1) * (PT0 * PT1);
            { float cm = c;
              cm = fmaxf(cm, __builtin_bit_cast(float, __builtin_amdgcn_update_dpp(0, __builtin_bit_cast(int, cm), 0xB1, 0xF, 0xF, true)));
              cm = fmaxf(cm, __builtin_bit_cast(float, __builtin_amdgcn_update_dpp(0, __builtin_bit_cast(int, cm), 0x4E, 0xF, 0xF, true)));
              cm = fmaxf(cm, __builtin_bit_cast(float, __builtin_amdgcn_update_dpp(0, __builtin_bit_cast(int, cm), 0x141, 0xF, 0xF, true)));
              cm = fmaxf(cm, __builtin_bit_cast(float, __builtin_amdgcn_update_dpp(0, __builtin_bit_cast(int, cm), 0x140, 0xF, 0xF, true)));
              const float c0 = __builtin_bit_cast(float, __builtin_amdgcn_readlane(__builtin_bit_cast(int, cm), 0)), c1 = __builtin_bit_cast(float, __builtin_amdgcn_readlane(__builtin_bit_cast(int, cm), 16));
              wcm = fmaxf(c0, c1); if (lane == 0) FLAG[wid] = wcm; }
            u32x4 pw0, pw1, pw2, pw3;
            pw0 = (u32x4){pk2(p0[0], p0[1]), pk2(p0[2], p0[3]), pk2(p0[4], p0[5]), pk2(p0[6], p0[7])}; pw1 = (u32x4){pk2(p0[8], p0[9]), pk2(p0[10], p0[11]), pk2(p0[12], p0[13]), pk2(p0[14], p0[15])};
            pw2 = (u32x4){pk2(p1[0], p1[1]), pk2(p1[2], p1[3]), pk2(p1[4], p1[5]), pk2(p1[6], p1[7])}; pw3 = (u32x4){pk2(p1[8], p1[9]), pk2(p1[10], p1[11]), pk2(p1[12], p1[13]), pk2(p1[14], p1[15])};
#pragma unroll
            for (int d0 = 0; d0 < 2; ++d0) { s16x4 lo[4], hh[4];
#pragma unroll
                for (int ks = 0; ks < 4; ++ks) {
                    asm volatile("ds_read_b64_tr_b16 %0,%1 offset:%c2" : "=&v"(lo[ks]) : "v"(vb), "i"(d0 * 4096 + ks * 1024) : "memory");
                    asm volatile("ds_read_b64_tr_b16 %0,%1 offset:%c2" : "=&v"(hh[ks]) : "v"(vb), "i"(d0 * 4096 + ks * 1024 + 512) : "memory"); }
                asm volatile("s_waitcnt lgkmcnt(0)" ::: "memory"); __builtin_amdgcn_sched_barrier(0);
#define PKV(k) (bf16x8){lo[k][0], lo[k][1], lo[k][2], lo[k][3], hh[k][0], hh[k][1], hh[k][2], hh[k][3]}
                f32x16& o = d0 ? o1 : o0;
                o = __builtin_amdgcn_mfma_f32_32x32x16_bf16(__builtin_bit_cast(bf16x8, pw0), PKV(0), o, 0, 0, 0);
                o = __builtin_amdgcn_mfma_f32_32x32x16_bf16(__builtin_bit_cast(bf16x8, pw1), PKV(1), o, 0, 0, 0);
                o = __builtin_amdgcn_mfma_f32_32x32x16_bf16(__builtin_bit_cast(bf16x8, pw2), PKV(2), o, 0, 0, 0);
                o = __builtin_amdgcn_mfma_f32_32x32x16_bf16(__builtin_bit_cast(bf16x8, pw3), PKV(3), o, 0, 0, 0);
#undef PKV
            }
        }
#undef AT_LOAD
        bf16* Ow = Q + (size_t)(b * SEQ + tqw - NMETA) * 1024 + h * 64;
#pragma unroll
        for (int r = 0; r < 16; ++r) { const int orow = crow(r, hi); Ow[(size_t)orow * 1024 + r32] = (bf16)f2bf(o0[r]); Ow[(size_t)orow * 1024 + 32 + r32] = (bf16)f2bf(o1[r]); }
        __syncthreads();
    }
}

__device__ __forceinline__ void corr_phase(const Args& A, LAS unsigned char* lds) {
    const int tid = threadIdx.x, lane = tid & 63, wid = __builtin_amdgcn_readfirstlane(tid >> 6), l15 = lane & 15, q = lane >> 4;
    LAS float* SA = (LAS float*)lds; LAS float* SB = SA + 4096;
    bf16* YR = (bf16*)((unsigned char*)A.out + DO_YR); const float* BONUS = (const float*)(A.ws + WS_BONUS);
    const bf16* V = (const bf16*)(A.ws + WS_PR + 2 * PL); const float* SEGS = (const float*)(A.ws + WS_SEGS);
    for (int task = blockIdx.x; task < NB * NH * 4; task += gridDim.x) {
        const int chain = task >> 2, seg = task & 3, b = chain >> 4, h = chain & 15;
        const int c_lo = seg ? SEG_C0 + 64 * (seg - 1) : 0, c_hi = SEG_C0 + 64 * seg;
        const bf16* Wc = (const bf16*)(chain < 33 ? (unsigned char*)A.out + (size_t)chain * WCH : (chain < 60 ? A.ws + WS_END + (size_t)(chain - 33) * WCH : (unsigned char*)A.out + DO_WTAIL + (size_t)(chain - 60) * WCH));
        __syncthreads();
        for (int i = tid; i < 4096; i += 512) SA[i] = seg ? SEGS[(size_t)((chain * 3) * 2) * 4096 + i] : 0.f;
        __syncthreads();
        LAS float* cur = SA; LAS float* nxt = SB;
        for (int s2 = 1; s2 < seg; ++s2) {
            const float* S0 = SEGS + (size_t)((chain * 3 + s2) * 2) * 4096; const float* Cm = S0 + 4096;
            const int row = tid >> 3, kb = (tid & 7) * 8;
            f32x4 a0 = *(const f32x4*)(S0 + row * 64 + kb), a1 = *(const f32x4*)(S0 + row * 64 + kb + 4);
#pragma unroll 8
            for (int j = 0; j < 64; ++j) { const float s = cur[row * 64 + j]; const f32x4 c0 = *(const f32x4*)(Cm + j * 64 + kb), c1 = *(const f32x4*)(Cm + j * 64 + kb + 4); a0 += c0 * s; a1 += c1 * s; }
            *(LAS f32x4*)(nxt + row * 64 + kb) = a0; *(LAS f32x4*)(nxt + row * 64 + kb + 4) = a1;
            __syncthreads();
            LAS float* tsw = cur; cur = nxt; nxt = tsw;
        }
        bf16x8 sinB[4][2];
#pragma unroll
        for (int m = 0; m < 4; ++m)
#pragma unroll
            for (int ks = 0; ks < 2; ++ks) { const LAS float* sp = cur + (16 * m + l15) * 64 + 32 * ks + 8 * q; const s16x4v c0 = cvt4(*(const LAS f32x4*)sp), c1 = cvt4(*(const LAS f32x4*)(sp + 4));
                sinB[m][ks] = (bf16x8){c0[0], c0[1], c0[2], c0[3], c1[0], c1[1], c1[2], c1[3]}; }
        const int colb = h * 64 + l15;
        float mv[4], gg[4], gb[4];
#pragma unroll
        for (int m = 0; m < 4; ++m) { mv[m] = A.mu[2048 + colb + 16 * m]; gg[m] = A.gn_g[colb + 16 * m]; gb[m] = A.gn_b[colb + 16 * m]; }
        const int cfirst = c_lo > 1 ? c_lo : 1;
#define CORR_LOAD(ck, W0, W1, YV, VT, VP, BN) do { \
            const bf16* wr_ = seg ? Wc + (size_t)(((ck) - SEG_C0) * CS + l15) * 64 + 8 * q : (const bf16*)SEGS; W0 = *(const bf16x8*)wr_; W1 = *(const bf16x8*)(wr_ + 32); \
            _Pragma("unroll") for (int r = 0; r < 4; ++r) { const int tg_ = (ck) * CS + 4 * q + r; const size_t row_ = (size_t)(b * SEQ + tg_ - NMETA), prow_ = (tg_ == NMETA) ? (size_t)(MR + NMETA - 1) : row_ - 1; \
                BN[r] = BONUS[row_ * 16 + h]; \
                _Pragma("unroll") for (int m = 0; m < 4; ++m) { YV[r][m] = YR[row_ * 1024 + colb + 16 * m]; VT[r][m] = V[row_ * 1024 + colb + 16 * m]; VP[r][m] = V[prow_ * 1024 + colb + 16 * m]; } } } while (0)
        const int nit = (c_hi - cfirst - wid + 7) / 8;
        if (nit > 0) {
            bf16x8 w0c, w1c; bf16 yc[4][4], vtc[4][4], vpc[4][4]; float bnc[4];
            CORR_LOAD(cfirst + wid, w0c, w1c, yc, vtc, vpc, bnc);
            for (int it = 0; it < nit; ++it) {
                const int chk = cfirst + wid + 8 * it, cn = (it + 1 < nit) ? chk + 8 : chk;
                bf16x8 w0n, w1n; bf16 yn[4][4], vtn[4][4], vpn[4][4]; float bnn[4];
                CORR_LOAD(cn, w0n, w1n, yn, vtn, vpn, bnn);
                f32x4 acc[4];
#pragma unroll
                for (int m = 0; m < 4; ++m) acc[m] = (f32x4){0.f, 0.f, 0.f, 0.f};
                if (seg) {
#pragma unroll
                    for (int m = 0; m < 4; ++m) { acc[m] = __builtin_amdgcn_mfma_f32_16x16x32_bf16(w0c, sinB[m][0], acc[m], 0, 0, 0); acc[m] = __builtin_amdgcn_mfma_f32_16x16x32_bf16(w1c, sinB[m][1], acc[m], 0, 0, 0); } }
#pragma unroll
                for (int r = 0; r < 4; ++r) { const int tg = chk * CS + 4 * q + r; const size_t row = (size_t)(b * SEQ + tg - NMETA);
                    float y[4]; float s = 0.f;
#pragma unroll
                    for (int m = 0; m < 4; ++m) { y[m] = bflo((unsigned)yc[r][m]) + acc[m][r]; s += y[m]; }
                    const float mean = dpp_sum16(s) * (1.f / 64.f); float sq = 0.f;
#pragma unroll
                    for (int m = 0; m < 4; ++m) { y[m] -= mean; sq += y[m] * y[m]; }
                    const float rstd = __builtin_amdgcn_rsqf(dpp_sum16(sq) * (1.f / 64.f) + 64e-5f);
#pragma unroll
                    for (int m = 0; m < 4; ++m) { const float vt = bflo((unsigned)vtc[r][m]), vp = bflo((unsigned)vpc[r][m]); const float vs = vt + (vp - vt) * mv[m]; YR[row * 1024 + colb + 16 * m] = f2bfh(y[m] * rstd * gg[m] + gb[m] + bnc[r] * vs); }
                }
                w0c = w0n; w1c = w1n;
#pragma unroll
                for (int r = 0; r < 4; ++r) { bnc[r] = bnn[r];
#pragma unroll
                    for (int m = 0; m < 4; ++m) { yc[r][m] = yn[r][m]; vtc[r][m] = vtn[r][m]; vpc[r][m] = vpn[r][m]; } }
            }
        }
#undef CORR_LOAD
    }
}

__device__ __forceinline__ void final_phase(const Args& A) {
    const int tid = threadIdx.x, lane = tid & 63, wave = tid >> 6;
    const bf16* RES = (const bf16*)(A.ws + WS_PR); const float* SSP = (const float*)(A.ws + WS_SSP);
    for (int m0 = blockIdx.x * 8 + wave; m0 < MR; m0 += gridDim.x * 16) {
        f32x4 xv[2][4], rv[2][4]; float ss[2] = {0.f, 0.f};
#pragma unroll
        for (int u = 0; u < 2; ++u) { const int m = m0 + u * gridDim.x * 8; if (m < MR) {
            const f32x4* xr = (const f32x4*)(A.x + (size_t)m * 1024) + lane; const unsigned long long* rr = (const unsigned long long*)(RES + (size_t)m * 1024) + lane;
#pragma unroll
            for (int j = 0; j < 4; ++j) { xv[u][j] = __builtin_nontemporal_load(xr + 64 * j); const unsigned long long w = __builtin_nontemporal_load(rr + 64 * j); const unsigned lo = (unsigned)w, hi = (unsigned)(w >> 32); rv[u][j] = (f32x4){bflo(lo), bfhi(lo), bflo(hi), bfhi(hi)}; }
            const f32x4* sp = (const f32x4*)(SSP + (size_t)m * 16);
#pragma unroll
            for (int i = 0; i < 4; ++i) { const f32x4 t = sp[i]; ss[u] += (t[0] + t[1]) + (t[2] + t[3]); } } }
#pragma unroll
        for (int u = 0; u < 2; ++u) { const int m = m0 + u * gridDim.x * 8; if (m < MR) {
            const float inv = __builtin_amdgcn_rsqf(ss[u] * (1.f / 1024.f) + 1e-6f);
            const f32x4* gr = (const f32x4*)A.post_g + lane; f32x4* orow = (f32x4*)(A.out + (size_t)m * 1024) + lane;
#pragma unroll
            for (int j = 0; j < 4; ++j) __builtin_nontemporal_store(xv[u][j] + rv[u][j] * inv * gr[64 * j], orow + 64 * j); } }
    }
}

#define XB_TMO      128
#define XB_XCNT(j)  (256  + 64 * (j))
#define XB_XSUB(j)  (1280 + 64 * (j))
#define XB_XGEN(j)  (2304 + 64 * (j))
#define XB_TOP      3328
#define XB_TOPGEN   3392
#define XCD_BAR_WORDS 3456
#define XB_SPIN_CAP (1u << 18)

__device__ __forceinline__ unsigned xb_ld(unsigned* p)              { return __hip_atomic_load(p, __ATOMIC_RELAXED, __HIP_MEMORY_SCOPE_AGENT); }
__device__ __forceinline__ unsigned xb_add(unsigned* p, unsigned v) { return __hip_atomic_fetch_add(p, v, __ATOMIC_RELAXED, __HIP_MEMORY_SCOPE_AGENT); }
__device__ __forceinline__ unsigned xb_xcc_id() { return (unsigned)__builtin_amdgcn_s_getreg((3 << 11) | 20) & 0xFu; }
#define XB_SPIN(cond, bar) do { unsigned _sp = 0; while (cond) { __builtin_amdgcn_s_sleep(1); \
    if ((++_sp & 255u) == 0u) { if (xb_ld(&(bar)[XB_TMO])) break; if (_sp > XB_SPIN_CAP) { atomicAdd(&(bar)[XB_TMO], 1u); break; } } } } while (0)

struct XcdBarrier {
    unsigned* bar; unsigned x;
    volatile LAS unsigned* st;
};

__device__ __forceinline__ XcdBarrier xcd_barrier_post(unsigned* bar, volatile LAS unsigned* st) {
    XcdBarrier b; b.bar = bar; b.x = xb_xcc_id(); b.st = st;
    if (threadIdx.x == 0) (void)xb_add(&bar[XB_XCNT(b.x)], 1u);
    return b;
}
__device__ __forceinline__ void xcd_barrier_complete(unsigned* bar, unsigned x, unsigned& nloc, unsigned& nx) {
    const unsigned G = gridDim.x * gridDim.y * gridDim.z;
    unsigned sum, cnt, mine, sp = 0u;
    for (;;) {
        sum = 0u; cnt = 0u; mine = 0u;
#pragma unroll
        for (unsigned j = 0; j < 16; ++j) { const unsigned c = xb_ld(&bar[XB_XCNT(j)]); sum += c; cnt += (c > 0u) ? 1u : 0u; mine = (j == x) ? c : mine; }
        if (sum == G) break;
        __builtin_amdgcn_s_sleep(1);
        if ((++sp & 255u) == 0u) { if (xb_ld(&bar[XB_TMO])) break; if (sp > XB_SPIN_CAP) { atomicAdd(&bar[XB_TMO], 1u); break; } }
    }
    nloc = mine > 0u ? mine : 1u; nx = cnt > 0u ? cnt : 1u;
}

__device__ __forceinline__ void xcd_barrier(const XcdBarrier& b) {
    asm volatile("s_waitcnt vmcnt(0)" ::: "memory");
    __syncthreads();
    if (threadIdx.x == 0) {
        unsigned* bar = b.bar;
        __builtin_amdgcn_s_waitcnt(0);
        unsigned nloc = b.st[0], nx = b.st[1];
        if (nloc == 0u) { xcd_barrier_complete(bar, b.x, nloc, nx); b.st[0] = nloc; b.st[1] = nx; }
        const unsigned old = xb_add(&bar[XB_XSUB(b.x)], 1u);
        const unsigned gen = old / nloc;
        if (old + 1u == (gen + 1u) * nloc) {
            __builtin_amdgcn_fence(__ATOMIC_RELEASE, "agent");
            asm volatile("s_waitcnt vmcnt(0)" ::: "memory");
            const unsigned og = xb_add(&bar[XB_TOP], 1u);
            const unsigned tg = og / nx;
            if (og + 1u == (tg + 1u) * nx) xb_add(&bar[XB_TOPGEN], 1u);
            else XB_SPIN(xb_ld(&bar[XB_TOPGEN]) == tg, bar);
            __builtin_amdgcn_fence(__ATOMIC_ACQUIRE, "agent");
            xb_add(&bar[XB_XGEN(b.x)], 1u);
            asm volatile("s_waitcnt vmcnt(0)" ::: "memory");
        } else {
            XB_SPIN(xb_ld(&bar[XB_XGEN(b.x)]) == gen, bar);
            __builtin_amdgcn_fence(__ATOMIC_ACQUIRE, "agent");
            asm volatile("s_waitcnt vmcnt(0)" ::: "memory");
        }
    }
    __syncthreads();
}

constexpr int NPH = 9;
__global__ void __launch_bounds__(512, 2) fwd_kernel(Args A) {
    extern __shared__ __attribute__((aligned(16))) unsigned char lds_raw[];
    LAS unsigned char* lds = (LAS unsigned char*)lds_raw;
    unsigned char* ws = A.ws; unsigned char* dob = (unsigned char*)A.out;
    const bf16* XN = (const bf16*)(ws + WS_XN); const bf16* WTIN = (const bf16*)(dob + DO_WTIN);
    bf16* P0 = (bf16*)(ws + WS_PR);
#define IN(k) (A.ph_lo <= (k) && (k) < A.ph_hi)
    if (threadIdx.x < 16) ((LAS unsigned*)(lds + LDS_XB))[threadIdx.x] = 0u;
    __syncthreads();
    const XcdBarrier xbar = xcd_barrier_post((unsigned*)(ws + WS_CTL), (volatile LAS unsigned*)(lds + LDS_XB));
#define SEAM(k) do { if (IN(k) && IN((k) + 1)) xcd_barrier(xbar); } while (0)
    if (IN(0)) p0_prologue(A, lds, false, 0, 1);
    SEAM(0);
    if (IN(1)) {
        pg8::Gemm g{XN, WTIN, MP, N1, 1024}; pg8::StaticOrder S; S.init(MP, N1, gridDim.x, blockIdx.x);
        pg8::EpiStore E{P0, PL / 2, 3, QSCALE, 24, (bf16*)(ws + WS_LORA)};
        pg8::gemm_phase<pg8::EpiStore, pg8::StaticOrder, true, true>(lds, g, S, E);
        { const int nun = (MP / 256) * (N1 / 256), rem = nun % (int)gridDim.x; const int first = (rem > 0 && rem < (int)gridDim.x) ? rem : 0;
          __syncthreads();
          if ((int)blockIdx.x >= first) p0_prologue(A, lds, true, ((int)blockIdx.x - first) * 8 + (int)(threadIdx.x >> 6), ((int)gridDim.x - first) * 8); }
    }
    SEAM(1);
    if (IN(2)) { for (int task = blockIdx.x; task < NB * NH * 4; task += gridDim.x) scan_chain(A, lds, task >> 2, task & 3); __syncthreads(); attn_phase(A, lds); }
    SEAM(2);
    if (IN(3)) corr_phase(A, lds);
    SEAM(3);
    if (IN(4)) {
        pg8::Gemm g{XN, WTIN + (size_t)6400 * 1024, MR, 2048, 1024}; pg8::StaticOrder S; S.init(MR, 2048, gridDim.x, blockIdx.x);
        pg8::EpiGate E{(bf16*)(dob + DO_YR), P0 + 3 * (PL / 2)};
        pg8::gemm_phase<pg8::EpiGate, pg8::StaticOrder, true, true>(lds, g, S, E);
    }
    SEAM(4);
    if (IN(5)) {
        { pg8::Gemm g{(const bf16*)(dob + DO_YR), (const bf16*)(dob + DO_WPR), MR, 1024, 1024}; pg8::StaticOrder S; S.init(MR, 1024, gridDim.x, blockIdx.x);
          pg8::EpiStore E{P0 + 1 * (PL / 2), 0, -1, 1.f, -1, nullptr}; pg8::gemm_phase<pg8::EpiStore, pg8::StaticOrder, true, true>(lds, g, S, E); }
        { pg8::Gemm g{P0 + 3 * (PL / 2), (const bf16*)(dob + DO_WPS), MR, 1024, 1024}; pg8::StaticOrder S; S.init(MR, 1024, gridDim.x, blockIdx.x);
          pg8::EpiStore E{P0 + 4 * (PL / 2), 0, -1, 1.f, -1, nullptr}; pg8::gemm_phase<pg8::EpiStore, pg8::StaticOrder, true, true>(lds, g, S, E); }
    }
    SEAM(5);
    if (IN(6)) {
        pg8::Gemm g{XN, WTIN + (size_t)8448 * 1024, MR, 2048, 1024}; pg8::StaticOrder S; S.init(MR, 2048, gridDim.x, blockIdx.x);
        pg8::EpiMerge E{P0 + 1 * (PL / 2), P0 + 4 * (PL / 2), P0 + 2 * (PL / 2)};
        pg8::gemm_phase<pg8::EpiMerge, pg8::StaticOrder, true, true>(lds, g, S, E);
    }
    SEAM(6);
    if (IN(7)) {
        pg8::Gemm g{P0 + 2 * (PL / 2), (const bf16*)(dob + DO_WOUT), MR, 1024, 1024}; pg8::StaticOrder S; S.init(MR, 1024, gridDim.x, blockIdx.x);
        pg8::EpiOut E{(bf16*)(ws + WS_PR), (float*)(ws + WS_SSP)};
        pg8::gemm_phase<pg8::EpiOut, pg8::StaticOrder, true, true>(lds, g, S, E);
    }
    SEAM(7);
    if (IN(8)) final_phase(A);
#undef IN
#undef SEAM
}

#ifndef N_LAUNCHES
#define N_LAUNCHES 1
#endif
extern "C" void kernel_launch(void* const* d_in, const int* in_sizes, int n_in, void* d_out, int out_size, void* d_ws, size_t ws_size, hipStream_t stream) {
    static int grid = 0;
    if (grid == 0) {
        int dev = 0, cus = 0, per_cu = 0;
        hipGetDevice(&dev); hipDeviceGetAttribute(&cus, hipDeviceAttributeMultiprocessorCount, dev);
        hipFuncSetAttribute((const void*)fwd_kernel, hipFuncAttributeMaxDynamicSharedMemorySize, LDS_BYTES);
        if (hipOccupancyMaxActiveBlocksPerMultiprocessor(&per_cu, (const void*)fwd_kernel, 512, LDS_BYTES) != hipSuccess || per_cu < 1) per_cu = 1;
        (void)hipGetLastError();
        grid = cus * per_cu; if (grid > 256) grid = 256;
        if (n_in != 18 || ws_size < WS_END) { fprintf(stderr, "kernel_launch: unexpected inputs (n_in %d, ws %zu)\n", n_in, ws_size); }
    }
    (void)hipMemsetAsync((unsigned char*)d_ws + WS_CTL, 0, CTL_BYTES, stream);
    Args a{};
    const float** pf = (const float**)&a;
    for (int i = 0; i < 18; ++i) pf[i] = (const float*)d_in[i];
    a.out = (float*)d_out; a.ws = (unsigned char*)d_ws;
    for (int li = 0; li < N_LAUNCHES; ++li) {
        a.ph_lo = (N_LAUNCHES == 1) ? 0 : li; a.ph_hi = (N_LAUNCHES == 1) ? NPH : li + 1;
        void* args[] = {&a};
        hipError_t e = hipLaunchCooperativeKernel((const void*)fwd_kernel, dim3(grid), dim3(512), args, LDS_BYTES, stream);
        if (e != hipSuccess) { fprintf(stderr, "cooperative launch failed: %s (grid %d)\n", hipGetErrorString(e), grid); break; }
    }
}
```

```cpp
#include <hip/hip_runtime.h>
#include <cstdio>
#include <cstdint>
namespace pg8 {
#define PG8_LAS __attribute__((address_space(3)))
typedef unsigned short bf16_t;
typedef short bf16x8 __attribute__((ext_vector_type(8)));
typedef float f32x4 __attribute__((ext_vector_type(4)));
typedef unsigned u32x4 __attribute__((ext_vector_type(4)));
constexpr int BM = 256, BK = 64, HALF = 128, HTB = HALF * BK * 2  , STAGE_BYTES = 8 * HTB, NXCD = 8, WGM = 8;

__host__ __device__ __forceinline__ int lds_byte(int r, int c) { const int st = (r >> 4) * 2 + (c >> 5), rr = r & 15, cc = c & 31, ob = rr * 64 + cc * 2; return st * 1024 + (ob ^ (((ob >> 9) & 1) << 5)); }
__host__ __device__ __forceinline__ void stage_rc(int b, int& R, int& C) { const int st = b / 1024, sb = b % 1024, swz = sb ^ (((sb >> 9) & 1) << 5); R = (st >> 1) * 16 + swz / 64; C = (st & 1) * 32 + (swz % 64) / 2; }
__host__ __device__ __forceinline__ int perm32(int rho) { const int n = rho >> 4, i = rho & 15; return 8 * (i >> 2) + 4 * n + (i & 3); }

struct Unit { int pm, pn; };
struct Gemm { const bf16_t* A; const bf16_t* Bt; int M, N, K; };

struct StaticOrder {
    int nM, nN, nwg, G, c;
    __host__ __device__ void init(int M, int N, int G_, int c_) { nM = M / BM; nN = N / BM; nwg = nM * nN; G = G_; c = c_; }
    __host__ __device__ bool next(int i, Unit& u) const {
        const long L = (long)i * G + c; if (L >= nwg) return false;
        int wgid = (int)L; { const int q = nwg / NXCD, r = nwg % NXCD, xcd = wgid % NXCD, off = wgid / NXCD; wgid = (xcd < r ? xcd * (q + 1) : r * (q + 1) + (xcd - r) * q) + off; }
        const int nig = WGM * nN, gid = wgid / nig, fm = gid * WGM, gsz = (nM - fm) < WGM ? (nM - fm) : WGM;
        u.pm = fm + ((wgid % nig) % gsz); u.pn = (wgid % nig) / gsz; return true;
    }
    __device__ __forceinline__ void a_ready(const Unit&) const {}
    __device__ __forceinline__ void done(const Unit&) const {}
};
__device__ __forceinline__ unsigned cvt_pk_bf16(float lo, float hi) { unsigned r; asm volatile("v_cvt_pk_bf16_f32 %0, %1, %2" : "=v"(r) : "v"(lo), "v"(hi)); return r; }
typedef float f32x2 __attribute__((ext_vector_type(2)));
__device__ __forceinline__ float bf_lo(unsigned w) { return __uint_as_float(w << 16); }
__device__ __forceinline__ float bf_hi(unsigned w) { return __uint_as_float(w & 0xffff0000u); }
__device__ __forceinline__ void unpack8(const u32x4 w, float (&f)[8]) { f[0] = bf_lo(w.x); f[1] = bf_hi(w.x); f[2] = bf_lo(w.y); f[3] = bf_hi(w.y); f[4] = bf_lo(w.z); f[5] = bf_hi(w.z); f[6] = bf_lo(w.w); f[7] = bf_hi(w.w); }
__device__ __forceinline__ u32x4 pack8(const float (&f)[8]) { u32x4 w; w.x = cvt_pk_bf16(f[0], f[1]); w.y = cvt_pk_bf16(f[2], f[3]); w.z = cvt_pk_bf16(f[4], f[5]); w.w = cvt_pk_bf16(f[6], f[7]); return w; }
__device__ __forceinline__ float sigmoidf_(float x) { return __builtin_amdgcn_rcpf(1.0f + __builtin_amdgcn_exp2f(-1.4426950408889634f * x)); }

struct EpiStore {
    static constexpr bool PERM = true, AFTER_DRAIN = false;
    bf16_t* base; size_t plane_stride; int qplane; float qscale; int lora_tile; bf16_t* lora;
    __device__ __forceinline__ void operator()(const f32x4 (&acc)[2][2][4][2], const Unit& u, int wr, int wc, int fr, int fq) const {
        bf16_t* dst; int ld, colt; float sc = 1.f;
        if (u.pn == lora_tile) { dst = lora; ld = 256; colt = 0; }
        else { const int pl = u.pn >> 2; dst = base + (size_t)pl * plane_stride; ld = 1024; colt = (u.pn & 3) * 256; if (pl == qplane) sc = qscale; }
        const int row0 = u.pm * BM + wr * 64 + fr, col0 = colt + wc * 32 + 8 * fq;
#pragma unroll
        for (int ai = 0; ai < 2; ++ai)
#pragma unroll
            for (int m = 0; m < 4; ++m) { bf16_t* rowp = dst + (size_t)(row0 + ai * HALF + m * 16) * ld + col0;
#pragma unroll
                for (int bj = 0; bj < 2; ++bj) { const f32x4 v0 = acc[ai][bj][m][0] * sc, v1 = acc[ai][bj][m][1] * sc;
                    u32x4 w; w.x = cvt_pk_bf16(v0[0], v0[1]); w.y = cvt_pk_bf16(v0[2], v0[3]); w.z = cvt_pk_bf16(v1[0], v1[1]); w.w = cvt_pk_bf16(v1[2], v1[3]);
                    *(u32x4*)(rowp + bj * HALF) = w; } }
    }
};

struct EpiGate {
    static constexpr bool PERM = true, AFTER_DRAIN = false;
    bf16_t* YR; bf16_t* O;
    __device__ __forceinline__ void operator()(const f32x4 (&acc)[2][2][4][2], const Unit& u, int wr, int wc, int fr, int fq) const {
        const int row0 = u.pm * BM + wr * 64 + fr;
        bf16_t* Y = (u.pn < 4) ? YR : O;
#pragma unroll
        for (int bj = 0; bj < 2; ++bj) {
            const int col = (u.pn & 3) * 256 + bj * HALF + wc * 32 + 8 * fq;
#pragma unroll
            for (int ai = 0; ai < 2; ++ai)
#pragma unroll
                for (int m = 0; m < 4; ++m) {
                    const int row = row0 + ai * HALF + m * 16; float y[8], o[8];
                    unpack8(*(const u32x4*)(Y + (size_t)row * 1024 + col), y);
#pragma unroll
                    for (int i = 0; i < 8; ++i) { const float g = acc[ai][bj][m][i >> 2][i & 3]; o[i] = y[i] * g * sigmoidf_(g); }
                    *(u32x4*)(Y + (size_t)row * 1024 + col) = pack8(o); asm volatile("" ::: "memory");
                }
        }
    }
};

struct EpiMerge {
    static constexpr bool PERM = true, AFTER_DRAIN = false;
    const bf16_t* Pr; const bf16_t* Ps; bf16_t* MIX;
    __device__ __forceinline__ void operator()(const f32x4 (&acc)[2][2][4][2], const Unit& u, int wr, int wc, int fr, int fq) const {
        const int row0 = u.pm * BM + wr * 64 + fr, col = u.pn * 128 + wc * 32 + 8 * fq;
#pragma unroll
        for (int ai = 0; ai < 2; ++ai)
#pragma unroll
            for (int m = 0; m < 4; ++m) {
                const int row = row0 + ai * HALF + m * 16; float a[8], b[8], o[8];
                unpack8(*(const u32x4*)(Pr + (size_t)row * 1024 + col), a); unpack8(*(const u32x4*)(Ps + (size_t)row * 1024 + col), b);
#pragma unroll
                for (int i = 0; i < 8; ++i) o[i] = sigmoidf_(acc[ai][0][m][i >> 2][i & 3]) * a[i] + sigmoidf_(acc[ai][1][m][i >> 2][i & 3]) * b[i];
                *(u32x4*)(MIX + (size_t)row * 1024 + col) = pack8(o); asm volatile("" ::: "memory");
            }
    }
};

struct EpiOut {
    static constexpr bool PERM = true, AFTER_DRAIN = false;
    bf16_t* RES; float* SSP;
    __device__ __forceinline__ void operator()(const f32x4 (&acc)[2][2][4][2], const Unit& u, int wr, int wc, int fr, int fq) const {
        const int row0 = u.pm * BM + wr * 64 + fr, col0 = u.pn * 256 + wc * 32 + 8 * fq;
#pragma unroll
        for (int ai = 0; ai < 2; ++ai)
#pragma unroll
            for (int m = 0; m < 4; ++m) {
                const int row = row0 + ai * HALF + m * 16; float s = 0.f;
#pragma unroll
                for (int bj = 0; bj < 2; ++bj) { const f32x4 v0 = acc[ai][bj][m][0], v1 = acc[ai][bj][m][1];
                    s += (v0[0] * v0[0] + v0[1] * v0[1]) + (v0[2] * v0[2] + v0[3] * v0[3]) + (v1[0] * v1[0] + v1[1] * v1[1]) + (v1[2] * v1[2] + v1[3] * v1[3]);
                    u32x4 w; w.x = cvt_pk_bf16(v0[0], v0[1]); w.y = cvt_pk_bf16(v0[2], v0[3]); w.z = cvt_pk_bf16(v1[0], v1[1]); w.w = cvt_pk_bf16(v1[2], v1[3]);
                    *(u32x4*)(RES + (size_t)row * 1024 + col0 + bj * HALF) = w; }
                s += __shfl_xor(s, 16); s += __shfl_xor(s, 32);
                if (fq == 0) SSP[(size_t)row * 16 + u.pn * 4 + wc] = s;
            }
    }
};
template <class Epi, class Sched, bool ALIGN_EPI = false, bool SP2 = false>
__device__ __forceinline__ void gemm_phase(PG8_LAS unsigned char* lds, const Gemm g, const Sched& S, const Epi& E) {
    const int tid = threadIdx.x, wid = __builtin_amdgcn_readfirstlane(tid >> 6), lane = tid & 63, wr = wid >> 2, wc = wid & 3, fr = lane & 15, fq = lane >> 4;
    const int K = g.K, nt = K / BK;
    unsigned voffA[2], voffB[2];
#pragma unroll
    for (int i = 0; i < 2; ++i) { int R, C; stage_rc(tid * 16 + i * 8192, R, C); const int Rb = Epi::PERM ? ((R & ~31) + perm32(R & 31)) : R;
        voffA[i] = (unsigned)(R * K + C) * 2u; voffB[i] = (unsigned)(Rb * K + C) * 2u; }
    const size_t kstep = (size_t)(BK * 2);
    const size_t hstep = (size_t)HALF * K * 2;
    const size_t tstep = 2 * hstep;
    const unsigned ldsw = (unsigned)wid * 1024u;
    const int aoff = lds_byte(wr * 64 + fr, fq * 8), boff = lds_byte(wc * 32 + fr, fq * 8);
#define PG8_SA(b, h) (((b) * 2 + (h)) * HTB)
#define PG8_SB(b, h) ((4 + (b) * 2 + (h)) * HTB)
#define PG8_STAGE(bufoff, gbase, voff) do { _Pragma("unroll") for (int _i = 0; _i < 2; ++_i) \
        __builtin_amdgcn_global_load_lds((const unsigned*)((const char*)(gbase) + (voff)[_i]), (PG8_LAS unsigned*)(lds + (bufoff) + ldsw + _i * 8192), 16, 0, 0); } while (0)
#define PG8_LDA(dst, b, h) do { _Pragma("unroll") for (int m = 0; m < 4; ++m) _Pragma("unroll") for (int k = 0; k < 2; ++k) dst[m][k] = *(const PG8_LAS bf16x8*)(lds + PG8_SA(b, h) + aoff + m * 2048 + k * 1024); } while (0)
#define PG8_LDB(dst, b, h) do { _Pragma("unroll") for (int n = 0; n < 2; ++n) _Pragma("unroll") for (int k = 0; k < 2; ++k) dst[n][k] = *(const PG8_LAS bf16x8*)(lds + PG8_SB(b, h) + boff + n * 2048 + k * 1024); } while (0)
#define PG8_MMA(ai, bj, At, Bt) do { __builtin_amdgcn_s_setprio(1); _Pragma("unroll") for (int m = 0; m < 4; ++m) _Pragma("unroll") for (int n = 0; n < 2; ++n) _Pragma("unroll") for (int k = 0; k < 2; ++k) \
        acc[ai][bj][m][n] = __builtin_amdgcn_mfma_f32_16x16x32_bf16(Bt[n][k], At[m][k], acc[ai][bj][m][n], 0, 0, 0); __builtin_amdgcn_s_setprio(0); } while (0)
#define PG8_WAIT_V(n) asm volatile("s_waitcnt vmcnt(" #n ")" ::: "memory")
#define PG8_WAIT_L(n) asm volatile("s_waitcnt lgkmcnt(" #n ")" ::: "memory")
#define PG8_BAR __builtin_amdgcn_s_barrier()
#define PG8_SCHED __builtin_amdgcn_sched_barrier(0)
    Unit cur, nxt; int ui = 0;
    if (!S.next(0, cur)) return;
    f32x4 acc[2][2][4][2];
#pragma unroll
    for (int a = 0; a < 2; ++a)
#pragma unroll
        for (int b = 0; b < 2; ++b)
#pragma unroll
            for (int m = 0; m < 4; ++m)
#pragma unroll
                for (int n = 0; n < 2; ++n) acc[a][b][m][n] = (f32x4){0.f, 0.f, 0.f, 0.f};
    bf16x8 At[4][2], B0[2][2], B1[2][2];
    const char* cA = (const char*)g.A + (size_t)cur.pm * tstep; const char* cB = (const char*)g.Bt + (size_t)cur.pn * tstep;
    S.a_ready(cur);
    if constexpr (SP2) {
        PG8_STAGE(PG8_SB(0, 0), cB, voffB); PG8_STAGE(PG8_SB(0, 1), cB + hstep, voffB); PG8_STAGE(PG8_SA(0, 0), cA, voffA); PG8_STAGE(PG8_SA(0, 1), cA + hstep, voffA);
        if (wr == 1) PG8_BAR;
        PG8_WAIT_V(2); PG8_BAR;
        PG8_STAGE(PG8_SB(1, 0), cB + kstep, voffB); PG8_STAGE(PG8_SA(1, 0), cA + kstep, voffA); PG8_STAGE(PG8_SB(1, 1), cB + hstep + kstep, voffB);
        PG8_WAIT_V(6); PG8_BAR;
    } else {
        PG8_STAGE(PG8_SB(0, 0), cB, voffB); PG8_STAGE(PG8_SA(0, 0), cA, voffA); PG8_STAGE(PG8_SB(0, 1), cB + hstep, voffB); PG8_STAGE(PG8_SA(0, 1), cA + hstep, voffA);
        if (wr == 1) PG8_BAR;
        PG8_WAIT_V(4); PG8_BAR;
        PG8_STAGE(PG8_SB(1, 0), cB + kstep, voffB); PG8_STAGE(PG8_SA(1, 0), cA + kstep, voffA); PG8_STAGE(PG8_SB(1, 1), cB + hstep + kstep, voffB);
        PG8_WAIT_V(6); PG8_BAR;
    }
    for (;;) {
        const bool has_next = S.next(ui + 1, nxt);
        const char* nA = has_next ? (const char*)g.A + (size_t)nxt.pm * tstep : cA; const char* nB = has_next ? (const char*)g.Bt + (size_t)nxt.pn * tstep : cB;
        for (int t = 0; t < nt; t += 2) {
            const bool last = (t == nt - 2);
            const char* a1 = cA + (size_t)(t + 1) * kstep;
            const char* a2 = last ? nA : cA + (size_t)(t + 2) * kstep; const char* b2 = last ? nB : cB + (size_t)(t + 2) * kstep;
            const char* a3 = a2 + kstep; const char* b3 = b2 + kstep;
            if (last && has_next) S.a_ready(nxt);
            if constexpr (SP2) {
            PG8_LDB(B0, 0, 0); PG8_LDB(B1, 0, 1); PG8_SCHED; PG8_LDA(At, 0, 0); PG8_STAGE(PG8_SA(1, 1), a1 + hstep, voffA);
            PG8_WAIT_V(8); PG8_WAIT_L(0); PG8_BAR; PG8_MMA(0, 0, At, B0); PG8_MMA(0, 1, At, B1); PG8_BAR; PG8_SCHED;
            PG8_LDA(At, 0, 1); PG8_STAGE(PG8_SB(0, 0), b2, voffB); PG8_STAGE(PG8_SB(0, 1), b2 + hstep, voffB); PG8_STAGE(PG8_SA(0, 0), a2, voffA);
            PG8_WAIT_V(8); PG8_WAIT_L(0); PG8_BAR; PG8_MMA(1, 0, At, B0); PG8_MMA(1, 1, At, B1); PG8_BAR; PG8_SCHED;
            PG8_LDB(B0, 1, 0); PG8_LDB(B1, 1, 1); PG8_SCHED; PG8_LDA(At, 1, 0); PG8_STAGE(PG8_SA(0, 1), a2 + hstep, voffA);
            PG8_WAIT_V(8); PG8_WAIT_L(0); PG8_BAR; PG8_MMA(0, 0, At, B0); PG8_MMA(0, 1, At, B1); PG8_BAR; PG8_SCHED;
            PG8_LDA(At, 1, 1); PG8_STAGE(PG8_SB(1, 0), b3, voffB); PG8_STAGE(PG8_SB(1, 1), b3 + hstep, voffB); PG8_STAGE(PG8_SA(1, 0), a3, voffA);
            PG8_WAIT_V(8); PG8_WAIT_L(0); PG8_BAR; PG8_MMA(1, 0, At, B0); PG8_MMA(1, 1, At, B1); PG8_BAR; PG8_SCHED;
            } else {
            PG8_LDB(B0, 0, 0); PG8_SCHED; PG8_LDA(At, 0, 0); PG8_STAGE(PG8_SA(1, 1), a1 + hstep, voffA);
            PG8_WAIT_L(8); PG8_BAR; PG8_WAIT_L(0); PG8_MMA(0, 0, At, B0); PG8_BAR; PG8_SCHED;
            PG8_LDB(B1, 0, 1); PG8_STAGE(PG8_SB(0, 0), b2, voffB);
            PG8_BAR; PG8_WAIT_L(0); PG8_MMA(0, 1, At, B1); PG8_BAR;
            PG8_LDA(At, 0, 1); PG8_STAGE(PG8_SA(0, 0), a2, voffA);
            PG8_BAR; PG8_WAIT_L(0); PG8_MMA(1, 0, At, B0); PG8_BAR; PG8_SCHED;
            PG8_STAGE(PG8_SB(0, 1), b2 + hstep, voffB);
            PG8_WAIT_V(6); PG8_BAR; PG8_MMA(1, 1, At, B1); PG8_BAR;
            PG8_LDB(B0, 1, 0); PG8_SCHED; PG8_LDA(At, 1, 0); PG8_STAGE(PG8_SA(0, 1), a2 + hstep, voffA);
            PG8_WAIT_L(8); PG8_BAR; PG8_WAIT_L(0); PG8_MMA(0, 0, At, B0); PG8_BAR; PG8_SCHED;
            PG8_LDB(B1, 1, 1); PG8_STAGE(PG8_SB(1, 0), b3, voffB);
            PG8_BAR; PG8_WAIT_L(0); PG8_MMA(0, 1, At, B1); PG8_BAR;
            PG8_LDA(At, 1, 1); PG8_STAGE(PG8_SA(1, 0), a3, voffA);
            PG8_BAR; PG8_WAIT_L(0); PG8_MMA(1, 0, At, B0); PG8_BAR; PG8_SCHED;
            PG8_STAGE(PG8_SB(1, 1), b3 + hstep, voffB);
            PG8_WAIT_V(6); PG8_BAR; PG8_MMA(1, 1, At, B1); PG8_BAR;
            }
        }
        if constexpr (ALIGN_EPI) { if (wr == 0) PG8_BAR; }
        if constexpr (!Epi::AFTER_DRAIN) { E(acc, cur, wr, wc, fr, fq); S.done(cur); }
        if (!has_next) break;
#pragma unroll
        for (int a = 0; a < 2; ++a)
#pragma unroll
            for (int b = 0; b < 2; ++b)
#pragma unroll
                for (int m = 0; m < 4; ++m)
#pragma unroll
                    for (int n = 0; n < 2; ++n) acc[a][b][m][n] = (f32x4){0.f, 0.f, 0.f, 0.f};
        cur = nxt; cA = nA; cB = nB; ++ui;
        if constexpr (ALIGN_EPI) { if (wr == 1) PG8_BAR; }
    }
    PG8_WAIT_V(0);
    if constexpr (!ALIGN_EPI) { if (wr == 0) PG8_BAR; }
    PG8_BAR;
    if constexpr (Epi::AFTER_DRAIN) { E.fused(acc, cur, wr, wc, fr, fq, lds, wid, lane); S.done(cur); }
#undef PG8_SA
#undef PG8_SB
#undef PG8_STAGE
#undef PG8_LDA
#undef PG8_LDB
#undef PG8_MMA
#undef PG8_WAIT_V
#undef PG8_WAIT_L
#undef PG8_BAR
#undef PG8_SCHED
}
}
#define LAS __attribute__((address_space(3)))
typedef unsigned short bf16;
typedef unsigned u32x4 __attribute__((ext_vector_type(4)));
typedef float f32x4 __attribute__((ext_vector_type(4)));
typedef float f32x16 __attribute__((ext_vector_type(16)));
typedef short bf16x8 __attribute__((ext_vector_type(8)));
typedef short s16x4 __attribute__((ext_vector_type(4)));

constexpr int NB = 4, SEQ = 4096, DM = 1024, NMETA = 16, LTOT = SEQ + NMETA, NH = 16;
constexpr int MR = NB * SEQ;
constexpr int MP = MR + 256;
constexpr int N1 = 6400;
constexpr int NWT = 10496;
constexpr size_t PL = (size_t)MP * 1024 * 2;
constexpr size_t MiB = 1u << 20;
constexpr size_t WS_SSP = 0;
constexpr size_t WS_BONUS = 1 * MiB;
constexpr size_t WS_STAT = 2 * MiB;
constexpr size_t WS_PR = 10 * MiB;
constexpr size_t WS_LORA = WS_PR + 6 * PL;
constexpr size_t WS_XN = WS_LORA + (size_t)MP * 256 * 2;
constexpr size_t WS_END = WS_XN + PL;
static_assert(WS_END <= 256 * MiB, "ws map");
constexpr size_t DO_WTIN = 0;
constexpr size_t DO_WPR = DO_WTIN + (size_t)NWT * 1024 * 2;
constexpr size_t DO_WPS = DO_WPR + 2 * MiB;
constexpr size_t DO_WOUT = DO_WPS + 2 * MiB;
constexpr size_t DO_YR = DO_WOUT + 2 * MiB;
static_assert(DO_YR + (size_t)MR * 1024 * 2 <= (size_t)MR * 1024 * 4, "d_out map");
constexpr size_t WS_SEGS = 2 * MiB;
constexpr size_t WS_CTL = 8 * MiB, CTL_BYTES = 16384;
constexpr int LDS_XB = 147456 - 64;
constexpr size_t WCH = 3072 * 64 * 2;
constexpr size_t DO_WTAIL = DO_YR + (size_t)MR * 1024 * 2;
static_assert(33 * WCH <= (size_t)6400 * 2048 && WS_END + 27 * WCH <= 256 * MiB && DO_WTAIL + 4 * WCH <= (size_t)MR * 1024 * 4 && 64 * 3 * 2 * 16384 <= 8 * MiB, "W / SEGS map");
constexpr int SEG_C0 = 65;
constexpr int LDS_BYTES = 147456;
constexpr float QSCALE = 0.125f * 1.4426950408889634f;

__device__ __forceinline__ unsigned f2bf(float f) { unsigned u = __builtin_bit_cast(unsigned, f); return (u + 0x7fffu + ((u >> 16) & 1u)) >> 16; }
typedef float f32x2_t __attribute__((ext_vector_type(2))); typedef __bf16 bf16x2_t __attribute__((ext_vector_type(2)));
__device__ __forceinline__ unsigned pk2(float lo, float hi) { f32x2_t v = {lo, hi}; bf16x2_t b = __builtin_convertvector(v, bf16x2_t); return __builtin_bit_cast(unsigned, b); }
__device__ __forceinline__ unsigned short f2bfh(float f) { return (unsigned short)(pk2(f, 0.f) & 0xffffu); }
__device__ __forceinline__ float bflo(unsigned w) { return __uint_as_float(w << 16); }
__device__ __forceinline__ float bfhi(unsigned w) { return __uint_as_float(w & 0xffff0000u); }
__device__ __forceinline__ float wave_sum(float v) {
#pragma unroll
    for (int o = 1; o < 64; o <<= 1) v += __shfl_xor(v, o);
    return v;
}
#define LDS_WAIT() asm volatile("s_waitcnt lgkmcnt(0)" ::: "memory")

struct Args {
    const float *x, *meta, *pre_g, *post_g, *w_in, *mu, *w0, *w_up, *a0, *a_up, *k_k, *k_a, *r_k, *gn_g, *gn_b, *w_pr, *w_ps, *w_out;
    float* out; unsigned char* ws; int ph_lo, ph_hi;
};

__device__ __forceinline__ int wtin_src(int r0) {
    if (r0 < 3072) return r0;
    if (r0 < 6144) return 4224 + (r0 - 3072);
    if (r0 < 6272) return 3072 + (r0 - 6144);
    if (r0 < 6400) return -1;
    if (r0 < 7424) return 3200 + (r0 - 6400);
    if (r0 < 8448) return 7296 + (r0 - 7424);
    const int q = r0 - 8448, p = q >> 8, bj = (q >> 7) & 1, i = q & 127;
    return 8320 + 1024 * bj + 128 * p + i;
}
__device__ __forceinline__ void transpose_item(const float* W, int ldw, int srccol, int k0, bf16* WT, int drow, LAS float* scr, int lane) {
    float tv[32];
#pragma unroll
    for (int i = 0; i < 32; ++i) { const int kk = 2 * i + (lane >> 5); tv[i] = srccol >= 0 ? W[(size_t)(k0 + kk) * ldw + srccol + (lane & 31)] : 0.f; }
#pragma unroll
    for (int i = 0; i < 32; ++i) { const int kk = 2 * i + (lane >> 5); scr[kk * 33 + (lane & 31)] = tv[i]; }
    LDS_WAIT(); asm volatile("" ::: "memory");
    const int c = lane & 7;
#pragma unroll
    for (int j = 0; j < 4; ++j) { const int n = (lane >> 3) + 8 * j; const LAS float* s = scr + (8 * c) * 33 + n;
        u32x4 o; o.x = pk2(s[0 * 33], s[1 * 33]); o.y = pk2(s[2 * 33], s[3 * 33]); o.z = pk2(s[4 * 33], s[5 * 33]); o.w = pk2(s[6 * 33], s[7 * 33]);
        *(u32x4*)(WT + (size_t)(drow + n) * 1024 + k0 + 8 * c) = o; }
    LDS_WAIT(); asm volatile("" ::: "memory");
}
__device__ __forceinline__ void p0_prologue(const Args& A, LAS unsigned char* lds, const bool late, const int gw_l, const int ngw_l) {
    const int tid = threadIdx.x, lane = tid & 63, wave = tid >> 6;
    LAS float* scr = (LAS float*)(lds + wave * 16384);
    const int gw = blockIdx.x * 8 + wave, NGW = gridDim.x * 8;
    bf16* WTIN = (bf16*)((unsigned char*)A.out + DO_WTIN); bf16* WPR = (bf16*)((unsigned char*)A.out + DO_WPR); bf16* WPS = (bf16*)((unsigned char*)A.out + DO_WPS); bf16* WOUT = (bf16*)((unsigned char*)A.out + DO_WOUT);
    constexpr int I_IN = (NWT / 32) * 16, I_SQ = 32 * 16, I_EARLY = (N1 / 32) * 16;
    const int it_lo = late ? I_EARLY + gw_l : gw, it_hi = late ? I_IN + 3 * I_SQ : I_EARLY, it_st = late ? ngw_l : NGW;
    for (int it = it_lo; it < it_hi; it += it_st) {
        if (it < I_IN) { const int g = it >> 4, kb = it & 15; transpose_item(A.w_in, 10368, wtin_src(32 * g), 64 * kb, WTIN, 32 * g, scr, lane); }
        else { const int r = it - I_IN, w = r / I_SQ, q = r % I_SQ, g = q >> 4, kb = q & 15;
            transpose_item(w == 0 ? A.w_pr : (w == 1 ? A.w_ps : A.w_out), 1024, 32 * g, 64 * kb, w == 0 ? WPR : (w == 1 ? WPS : WOUT), 32 * g, scr, lane); }
    }
    if (late) return;
    bf16* XN = (bf16*)(A.ws + WS_XN);
    for (int m0 = gw; m0 < MP; m0 += 2 * NGW) {
        f32x4 v[2][4]; float s[2] = {0.f, 0.f};
#pragma unroll
        for (int u = 0; u < 2; ++u) { const int m = m0 + u * NGW;
            if (m < MR + NMETA) { const float* src = (m < MR) ? A.x + (size_t)m * 1024 : A.meta + (size_t)(m - MR) * 1024; const f32x4* xr = (const f32x4*)src + lane;
#pragma unroll
                for (int j = 0; j < 4; ++j) v[u][j] = __builtin_nontemporal_load(xr + 64 * j); }
            else {
#pragma unroll
                for (int j = 0; j < 4; ++j) v[u][j] = (f32x4){0.f, 0.f, 0.f, 0.f}; } }
#pragma unroll
        for (int u = 0; u < 2; ++u)
#pragma unroll
            for (int j = 0; j < 4; ++j) s[u] += (v[u][j].x * v[u][j].x + v[u][j].y * v[u][j].y) + (v[u][j].z * v[u][j].z + v[u][j].w * v[u][j].w);
#pragma unroll
        for (int u = 0; u < 2; ++u) { const int m = m0 + u * NGW; if (m < MP) {
            const float inv = __builtin_amdgcn_rsqf(wave_sum(s[u]) * (1.f / 1024.f) + 1e-6f);
            unsigned long long* o8 = (unsigned long long*)(XN + (size_t)m * 1024) + lane; const f32x4* gr = (const f32x4*)A.pre_g + lane;
#pragma unroll
            for (int j = 0; j < 4; ++j) { const f32x4 g = gr[64 * j]; o8[64 * j] = (unsigned long long)pk2(v[u][j].x * inv * g.x, v[u][j].y * inv * g.y) | ((unsigned long long)pk2(v[u][j].z * inv * g.z, v[u][j].w * inv * g.w) << 32); } } }
    }
}

constexpr int CS = 16, NCHK = LTOT / CS;
typedef short s16x4v __attribute__((ext_vector_type(4)));
__device__ __forceinline__ int tok_row(int b, int t) { return t < NMETA ? MR + t : b * SEQ + t - NMETA; }
__device__ __forceinline__ float dpp_sum16(float x) {
    x += __builtin_bit_cast(float, __builtin_amdgcn_update_dpp(0, __builtin_bit_cast(int, x), 0xB1, 0xF, 0xF, true));
    x += __builtin_bit_cast(float, __builtin_amdgcn_update_dpp(0, __builtin_bit_cast(int, x), 0x4E, 0xF, 0xF, true));
    x += __builtin_bit_cast(float, __builtin_amdgcn_update_dpp(0, __builtin_bit_cast(int, x), 0x141, 0xF, 0xF, true));
    x += __builtin_bit_cast(float, __builtin_amdgcn_update_dpp(0, __builtin_bit_cast(int, x), 0x140, 0xF, 0xF, true));
    return x;
}
__device__ __forceinline__ float wave_sum64(float x) { const float s = dpp_sum16(x); const int si = __builtin_bit_cast(int, s);
    return (__builtin_bit_cast(float, __builtin_amdgcn_readlane(si, 0)) + __builtin_bit_cast(float, __builtin_amdgcn_readlane(si, 16))) + (__builtin_bit_cast(float, __builtin_amdgcn_readlane(si, 32)) + __builtin_bit_cast(float, __builtin_amdgcn_readlane(si, 48))); }
__device__ __forceinline__ s16x4v cvt4(const f32x4 v) { typedef unsigned u32x2_t __attribute__((ext_vector_type(2))); u32x2_t w; w[0] = pk2(v[0], v[1]); w[1] = pk2(v[2], v[3]); return __builtin_bit_cast(s16x4v, w); }
constexpr int SC_SH = 0;
constexpr int SC_LOGD = SC_SH + 20480;
constexpr int SC_AA = SC_LOGD + 4096;
constexpr int SC_KKU = SC_AA + 4096;
constexpr int SC_KP = SC_KKU + 4096;
constexpr int SC_CUM = SC_KP + 4096;
constexpr int SC_SSQ = SC_CUM + 4352;
constexpr int SC_BNP = SC_SSQ + 256;
constexpr int SC_AF = SC_BNP + 256;
constexpr int SC_YOUT = SC_AF + 1024;
constexpr int SC_WOUT = SC_YOUT + 4096;
constexpr int SC_CST = SC_WOUT + 4096;
constexpr int SC_SET = SC_CST + 3072;
constexpr int TMS = 72;
constexpr int ST_AL = 0, ST_RB = 2304, ST_BTM = 4608, ST_KTM = 6912, ST_BT = 9216, ST_KT = 11264, ST_VT = 13312;
constexpr int ST_TT = 15360, ST_BB = 15872, ST_A2 = 16384, ST_B2 = 16896, ST_PC = 17408, ST_BON = 17664, ST_SIZE = 17792;
static_assert(SC_SET + 2 * ST_SIZE <= LDS_BYTES, "scan LDS");

#define LBAR() do { asm volatile("s_waitcnt lgkmcnt(0)" ::: "memory"); __builtin_amdgcn_s_barrier(); asm volatile("" ::: "memory"); } while (0)
__device__ __forceinline__ void scan_chain(const Args& A, LAS unsigned char* lds, const int chain, const int seg) {
    const int c_lo = seg ? SEG_C0 + 64 * (seg - 1) : 0, c_hi = SEG_C0 + 64 * seg;
    const int tid = threadIdx.x, lane = tid & 63, wid = __builtin_amdgcn_readfirstlane(tid >> 6), l15 = lane & 15, q = lane >> 4;
    const int b = chain >> 4, h = chain & 15;
    LAS float* SH = (LAS float*)(lds + SC_SH); LAS float* LOGD = (LAS float*)(lds + SC_LOGD); LAS float* AA = (LAS float*)(lds + SC_AA); LAS float* KKU = (LAS float*)(lds + SC_KKU);
    LAS float* KP = (LAS float*)(lds + SC_KP); LAS float* CUM = (LAS float*)(lds + SC_CUM); LAS float* SSQ = (LAS float*)(lds + SC_SSQ); LAS float* BNP = (LAS float*)(lds + SC_BNP);
    LAS float* AF = (LAS float*)(lds + SC_AF); LAS float* YOUT = (LAS float*)(lds + SC_YOUT); LAS float* WOUT = (LAS float*)(lds + SC_WOUT); LAS float* CST = (LAS float*)(lds + SC_CST);
    const bf16* PR = (const bf16*)(A.ws + WS_PR); const bf16* PK = (const bf16*)(A.ws + WS_PR + PL); const bf16* PV = (const bf16*)(A.ws + WS_PR + 2 * PL);
    const bf16* LORA = (const bf16*)(A.ws + WS_LORA);
    bf16* YR = (bf16*)((unsigned char*)A.out + DO_YR); float* BONUS = (float*)(A.ws + WS_BONUS);
    bf16* Wc = (bf16*)(chain < 33 ? (unsigned char*)A.out + (size_t)chain * WCH : (chain < 60 ? A.ws + WS_END + (size_t)(chain - 33) * WCH : (unsigned char*)A.out + DO_WTAIL + (size_t)(chain - 60) * WCH));
    __syncthreads();
    for (int i = tid; i < 768; i += 512) { const int a = i >> 6, j = i & 63; float v;
        if (a < 3) v = A.mu[a * 1024 + h * 64 + j]; else if (a == 3) v = A.mu[3072 + j]; else if (a == 4) v = A.mu[3136 + j];
        else if (a == 5) v = A.w0[h * 64 + j]; else if (a == 6) v = A.a0[h * 64 + j]; else if (a == 7) v = A.k_k[h * 64 + j]; else if (a == 8) v = A.k_a[h * 64 + j];
        else if (a == 9) v = A.r_k[h * 64 + j]; else if (a == 10) v = A.gn_g[h * 64 + j]; else v = A.gn_b[h * 64 + j];
        CST[i] = v; }
    const int ct = wid & 3;
    bf16x8 bw[2], ba[2];
#pragma unroll
    for (int ks = 0; ks < 2; ++ks)
#pragma unroll
        for (int j = 0; j < 8; ++j) { const int k = 32 * ks + 8 * q + j; const size_t o = (size_t)k * 1024 + h * 64 + 16 * ct + l15;
            bw[ks][j] = (short)f2bf(A.w_up[o]); ba[ks][j] = (short)f2bf(A.a_up[o]); }
    f32x4 sT[4];
#pragma unroll
    for (int m = 0; m < 4; ++m) sT[m] = (f32x4){0.f, 0.f, 0.f, 0.f};
    f32x4 sI[4];
#pragma unroll
    for (int m = 0; m < 4; ++m)
#pragma unroll
        for (int r = 0; r < 4; ++r) sI[m][r] = (16 * m + 4 * q + r == 16 * wid + l15) ? 1.f : 0.f;
    u32x4 pc[2], pp[2];
#define SCAN_ITEMS(I0, I1) const int I0 = (wid < 4) ? tid : ((wid >= 5) ? 448 + (tid - 320) : 0), I1 = (wid < 3) ? tid + 256 : I0
#define SCAN_ISSUE(c0) do { SCAN_ITEMS(i0_, i1_); _Pragma("unroll") for (int qq = 0; qq < 2; ++qq) { const int it = qq ? i1_ : i0_; \
        const int arr = it / (CS * 8), rem = it % (CS * 8), t = rem >> 3, cg = rem & 7; const int tg = (c0) * CS + t; \
        const int rc = tok_row(b, tg), rp = tok_row(b, tg > 0 ? tg - 1 : 0); \
        const bf16* bs = arr == 0 ? PR : (arr == 1 ? PK : (arr == 2 ? PV : LORA)); const int ld = arr < 3 ? 1024 : 256; const int co = arr < 3 ? h * 64 + 8 * cg : (arr == 3 ? 8 * cg : 64 + 8 * cg); \
        pc[qq] = *(const u32x4*)(bs + (size_t)rc * ld + co); pp[qq] = *(const u32x4*)(bs + (size_t)rp * ld + co); } } while (0)
#define SCAN_SHIFT(cc) do { SCAN_ITEMS(i0_, i1_); _Pragma("unroll") for (int qq = 0; qq < 2; ++qq) if (qq == 0 || wid < 3) { const int it = qq ? i1_ : i0_; \
        const int arr = it / (CS * 8), rem = it % (CS * 8), t = rem >> 3, cg = rem & 7; const int tg = (cc) * CS + t; \
        const u32x4 cu = pc[qq]; u32x4 pv = pp[qq]; if (tg == 0) pv = (u32x4){0u, 0u, 0u, 0u}; \
        const float fc[8] = {bflo(cu.x), bfhi(cu.x), bflo(cu.y), bfhi(cu.y), bflo(cu.z), bfhi(cu.z), bflo(cu.w), bfhi(cu.w)}; \
        const float fp[8] = {bflo(pv.x), bfhi(pv.x), bflo(pv.y), bfhi(pv.y), bflo(pv.z), bfhi(pv.z), bflo(pv.w), bfhi(pv.w)}; \
        LAS float* dst = SH + (arr * CS + t) * 64 + 8 * cg; const LAS float* mu = CST + arr * 64 + 8 * cg; \
        float sv_[8]; \
        _Pragma("unroll") for (int i = 0; i < 8; ++i) { float v = fc[i] + (fp[i] - fc[i]) * mu[i]; \
            if (arr == 3) { const float e = __builtin_amdgcn_exp2f(2.885390081777927f * v); v = 1.0f - 2.0f * __builtin_amdgcn_rcpf(1.0f + e); } \
            sv_[i] = v; } \
        if (arr < 3) { *(LAS f32x4*)dst = (f32x4){sv_[0], sv_[1], sv_[2], sv_[3]}; *(LAS f32x4*)(dst + 4) = (f32x4){sv_[4], sv_[5], sv_[6], sv_[7]}; } \
        else { *(LAS u32x4*)((LAS bf16*)(SH + 3 * CS * 64) + ((arr - 3) * CS + t) * TMS + 8 * cg) = (u32x4){pk2(sv_[0], sv_[1]), pk2(sv_[2], sv_[3]), pk2(sv_[4], sv_[5]), pk2(sv_[6], sv_[7])}; } } } while (0)
    SCAN_ISSUE(c_lo);
    __syncthreads();
    if (wid != 4) SCAN_SHIFT(c_lo);
    SCAN_ISSUE(c_lo + 1);
    __syncthreads();
#define SCAN_EPI() do { if (c >= 2) { \
        _Pragma("unroll") for (int i = 0; i < 4; ++i) { const int t = 4 * wid + i; const int tg = (c - 1) * CS + t; const size_t row = (size_t)(b * SEQ + tg - NMETA); \
            YR[row * 1024 + h * 64 + lane] = f2bfh(YOUT[t * 64 + lane]); \
            if (seg) Wc[(size_t)(tg - SEG_C0 * CS) * 64 + lane] = f2bfh(WOUT[t * 64 + lane]); \
            if (lane == 0) BONUS[row * 16 + h] = ((const LAS float*)(setc + ST_BON))[t]; } } } while (0)
    for (int c = c_lo; c <= c_hi; ++c) {
        const bool prod = c < c_hi, cons = c > c_lo;
        LAS unsigned char* setp = lds + SC_SET + (c & 1) * ST_SIZE;
        LAS unsigned char* setc = lds + SC_SET + ((c - 1) & 1) * ST_SIZE;
        if (wid < 4) {
            if (cons) {
                const int row = 16 * wid + l15;
                bf16x8 sb0, sb1;
#pragma unroll
                for (int r = 0; r < 4; ++r) { sb0[r] = cvt4(sT[0])[r]; sb0[4 + r] = cvt4(sT[1])[r]; sb1[r] = cvt4(sT[2])[r]; sb1[4 + r] = cvt4(sT[3])[r]; }
                const LAS bf16* ALr = (const LAS bf16*)(setc + ST_AL) + l15 * TMS; const LAS bf16* RBr = (const LAS bf16*)(setc + ST_RB) + l15 * TMS;
                bf16x8 al0, al1, rb0, rb1;
                { const s16x4v a = *(const LAS s16x4v*)(ALr + 4 * q), b2 = *(const LAS s16x4v*)(ALr + 16 + 4 * q), c2 = *(const LAS s16x4v*)(ALr + 32 + 4 * q), d2 = *(const LAS s16x4v*)(ALr + 48 + 4 * q);
                  al0 = (bf16x8){a[0], a[1], a[2], a[3], b2[0], b2[1], b2[2], b2[3]}; al1 = (bf16x8){c2[0], c2[1], c2[2], c2[3], d2[0], d2[1], d2[2], d2[3]}; }
                { const s16x4v a = *(const LAS s16x4v*)(RBr + 4 * q), b2 = *(const LAS s16x4v*)(RBr + 16 + 4 * q), c2 = *(const LAS s16x4v*)(RBr + 32 + 4 * q), d2 = *(const LAS s16x4v*)(RBr + 48 + 4 * q);
                  rb0 = (bf16x8){a[0], a[1], a[2], a[3], b2[0], b2[1], b2[2], b2[3]}; rb1 = (bf16x8){c2[0], c2[1], c2[2], c2[3], d2[0], d2[1], d2[2], d2[3]}; }
                const s16x4v bb = *(const LAS s16x4v*)((const LAS bf16*)(setc + ST_BB) + l15 * 16 + 4 * q), tt = *(const LAS s16x4v*)((const LAS bf16*)(setc + ST_TT) + l15 * 16 + 4 * q);
                const s16x4v a2 = *(const LAS s16x4v*)((const LAS bf16*)(setc + ST_A2) + l15 * 16 + 4 * q), b2v = *(const LAS s16x4v*)((const LAS bf16*)(setc + ST_B2) + l15 * 16 + 4 * q);
                const int qs = 4 * (q ^ ((l15 >> 2) & 3));
                const s16x4v vt = *(const LAS s16x4v*)((const LAS bf16*)(setc + ST_VT) + row * 16 + qs);
                const f32x4 z4 = {0.f, 0.f, 0.f, 0.f};
                f32x4 rhs = __builtin_amdgcn_mfma_f32_16x16x32_bf16(al0, sb0, z4, 0, 0, 0);
                rhs = __builtin_amdgcn_mfma_f32_16x16x32_bf16(al1, sb1, rhs, 0, 0, 0);
                rhs = __builtin_amdgcn_mfma_f32_16x16x16bf16_1k(bb, vt, rhs, 0, 0, 0);
                f32x4 y = __builtin_amdgcn_mfma_f32_16x16x32_bf16(rb0, sb0, z4, 0, 0, 0);
                y = __builtin_amdgcn_mfma_f32_16x16x32_bf16(rb1, sb1, y, 0, 0, 0);
                y = __builtin_amdgcn_mfma_f32_16x16x16bf16_1k(b2v, vt, y, 0, 0, 0);
                const f32x4 u = __builtin_amdgcn_mfma_f32_16x16x16bf16_1k(tt, cvt4(rhs), z4, 0, 0, 0);
                const s16x4v ub = cvt4(u);
                y = __builtin_amdgcn_mfma_f32_16x16x16bf16_1k(a2, ub, y, 0, 0, 0);
#pragma unroll
                for (int r = 0; r < 4; ++r) YOUT[(4 * q + r) * 64 + row] = y[r];
                bf16x8 ib0, ib1;
                { const s16x4v c0 = cvt4(sI[0]), c1 = cvt4(sI[1]), c2 = cvt4(sI[2]), c3 = cvt4(sI[3]);
                  ib0 = (bf16x8){c0[0], c0[1], c0[2], c0[3], c1[0], c1[1], c1[2], c1[3]}; ib1 = (bf16x8){c2[0], c2[1], c2[2], c2[3], c3[0], c3[1], c3[2], c3[3]}; }
                f32x4 rhsI = __builtin_amdgcn_mfma_f32_16x16x32_bf16(al0, ib0, z4, 0, 0, 0);
                rhsI = __builtin_amdgcn_mfma_f32_16x16x32_bf16(al1, ib1, rhsI, 0, 0, 0);
                f32x4 yI = __builtin_amdgcn_mfma_f32_16x16x32_bf16(rb0, ib0, z4, 0, 0, 0);
                yI = __builtin_amdgcn_mfma_f32_16x16x32_bf16(rb1, ib1, yI, 0, 0, 0);
                const f32x4 uI = __builtin_amdgcn_mfma_f32_16x16x16bf16_1k(tt, cvt4(rhsI), z4, 0, 0, 0);
                const s16x4v ubI = cvt4(uI);
                yI = __builtin_amdgcn_mfma_f32_16x16x16bf16_1k(a2, ubI, yI, 0, 0, 0);
#pragma unroll
                for (int r = 0; r < 4; ++r) WOUT[(4 * q + r) * 64 + row] = yI[r];
#pragma unroll
                for (int m = 0; m < 4; ++m) {
                    const s16x4v btm = *(const LAS s16x4v*)((const LAS bf16*)(setc + ST_BT) + (16 * m + l15) * 16 + qs), ktm = *(const LAS s16x4v*)((const LAS bf16*)(setc + ST_KT) + (16 * m + l15) * 16 + qs);
                    f32x4 s = __builtin_amdgcn_mfma_f32_16x16x16bf16_1k(btm, ub, sT[m], 0, 0, 0);
                    s = __builtin_amdgcn_mfma_f32_16x16x16bf16_1k(ktm, vt, s, 0, 0, 0);
                    const f32x4 pcv = *(const LAS f32x4*)((const LAS float*)(setc + ST_PC) + 16 * m + 4 * q);
                    sT[m] = s * pcv;
                    sI[m] = __builtin_amdgcn_mfma_f32_16x16x16bf16_1k(btm, ubI, sI[m], 0, 0, 0) * pcv;
                }
            }
        } else if (prod) {
            const int ct = wid - 4;
            f32x4 aw = {0.f, 0.f, 0.f, 0.f}, aa = {0.f, 0.f, 0.f, 0.f};
#pragma unroll
            for (int ks = 0; ks < 2; ++ks) {
                const LAS bf16* lw = (const LAS bf16*)(SH + 3 * CS * 64) + l15 * TMS + 32 * ks + 8 * q;
                const bf16x8 fw = *(const LAS bf16x8*)lw, fa = *(const LAS bf16x8*)(lw + CS * TMS);
                aw = __builtin_amdgcn_mfma_f32_16x16x32_bf16(fw, bw[ks], aw, 0, 0, 0);
                aa = __builtin_amdgcn_mfma_f32_16x16x32_bf16(fa, ba[ks], aa, 0, 0, 0);
            }
            const int j = 16 * ct + l15;
            const float w0j = CST[5 * 64 + j], a0j = CST[6 * 64 + j], kkj = CST[7 * 64 + j], kaj = CST[8 * 64 + j], rkj = CST[9 * 64 + j];
            float lg[4];
#pragma unroll
            for (int r = 0; r < 4; ++r) {
                const int t = 4 * q + r;
                const float sgw = __builtin_amdgcn_rcpf(1.0f + __builtin_amdgcn_exp2f(-1.4426950408889634f * (w0j + aw[r])));
                const float a = __builtin_amdgcn_rcpf(1.0f + __builtin_amdgcn_exp2f(-1.4426950408889634f * (a0j + aa[r])));
                const float ksh = SH[(1 * CS + t) * 64 + j], rsh = SH[(0 * CS + t) * 64 + j];
                const float kku = ksh * kkj, kp = ksh * (1.0f + (a - 1.0f) * kaj);
                lg[r] = -0.6065306597126334f * 1.4426950408889634f * sgw; AA[t * 64 + j] = a; KKU[t * 64 + j] = kku; KP[t * 64 + j] = kp;
            }
            { const float cp1 = lg[0], cp2 = cp1 + lg[1], cp3 = cp2 + lg[2], cp4 = cp3 + lg[3];
              LAS float* XQ = SSQ + ct * 64;
              XQ[lane] = cp4; asm volatile("s_waitcnt lgkmcnt(0)" ::: "memory");
              const float g0 = XQ[l15], g1 = XQ[l15 + 16], g2 = XQ[l15 + 32];
              const float off = (q > 0 ? g0 : 0.f) + (q > 1 ? g1 : 0.f) + (q > 2 ? g2 : 0.f);
              const float cpr[5] = {off, off + cp1, off + cp2, off + cp3, off + cp4};
#pragma unroll
              for (int r = 0; r < 4; ++r) { CUM[(4 * q + r) * 64 + j] = cpr[r]; LOGD[(4 * q + r) * 64 + j] = cpr[r + 1]; } }
        }
        LBAR();
        if (!prod) {
            if (wid < 4) { SCAN_EPI(); }
            LBAR();
            break;
        }
        { const int t0 = tid >> 6, k = tid & 63;
#pragma unroll
          for (int i = 0; i < 2; ++i) { const int t = t0 + 8 * i, e = t * 64 + k;
            const float kku_ = KKU[e], rsh_ = SH[(0 * CS + t) * 64 + k];
            const float rs = __builtin_amdgcn_rsqf(wave_sum64(kku_ * kku_) + 1e-12f), bon_ = wave_sum64(rsh_ * KP[e] * CST[9 * 64 + k]);
            const float c0 = CUM[e], c1 = LOGD[e];
            const float e0 = __builtin_amdgcn_exp2f(c0), e1 = __builtin_amdgcn_exp2f(c1), ie1 = __builtin_amdgcn_exp2f(-c1);
            const float kk = kku_ * rs;
            const unsigned w01 = pk2(kk * e0, rsh_ * e1), w23 = pk2(-kk * AA[e] * ie1, KP[e] * ie1); const bf16 al = (bf16)(w01 & 0xffffu), rb = (bf16)(w01 >> 16), bt = (bf16)(w23 & 0xffffu), kt = (bf16)(w23 >> 16);
            { const int et = t * TMS + k; ((LAS bf16*)(setp + ST_AL))[et] = al; ((LAS bf16*)(setp + ST_RB))[et] = rb; ((LAS bf16*)(setp + ST_BTM))[et] = bt; ((LAS bf16*)(setp + ST_KTM))[et] = kt; }
            const int tsw = 4 * ((t >> 2) ^ ((k >> 2) & 3)) + (t & 3);
            ((LAS bf16*)(setp + ST_BT))[k * 16 + tsw] = bt; ((LAS bf16*)(setp + ST_KT))[k * 16 + tsw] = kt;
            ((LAS bf16*)(setp + ST_VT))[k * 16 + tsw] = f2bfh(SH[(2 * CS + t) * 64 + k]);
            if (t == CS - 1) ((LAS float*)(setp + ST_PC))[k] = e1;
            if (k == 0) ((LAS float*)(setp + ST_BON))[t] = bon_; } }
        LBAR();
        if (wid >= 4) { const int p = wid - 4;
            const LAS bf16* ALr = (const LAS bf16*)(setp + ST_AL) + l15 * TMS; const LAS bf16* RBr = (const LAS bf16*)(setp + ST_RB) + l15 * TMS;
            const LAS bf16* BTr = (const LAS bf16*)(setp + ST_BTM) + l15 * TMS; const LAS bf16* KTr = (const LAS bf16*)(setp + ST_KTM) + l15 * TMS;
            const f32x4 z4 = {0.f, 0.f, 0.f, 0.f};
            if (p == 0) {
                f32x4 xt = z4, xa = z4;
#pragma unroll
                for (int ks = 0; ks < 2; ++ks) { const bf16x8 a = *(const LAS bf16x8*)(ALr + 32 * ks + 8 * q), bq = *(const LAS bf16x8*)(BTr + 32 * ks + 8 * q);
                    xt = __builtin_amdgcn_mfma_f32_16x16x32_bf16(a, bq, xt, 0, 0, 0); xa = __builtin_amdgcn_mfma_f32_16x16x32_bf16(bq, a, xa, 0, 0, 0); }
                f32x4 idn;
#pragma unroll
                for (int r = 0; r < 4; ++r) { const int rr = 4 * q + r; xt[r] = (l15 < rr) ? xt[r] : 0.f; xa[r] = (rr < l15) ? xa[r] : 0.f; idn[r] = (rr == l15) ? 1.f : 0.f; }
                s16x4v X = cvt4(xa), XT = cvt4(xt);
                f32x4 Tm = xa + idn, TmT = xt + idn;
                f32x4 x2 = __builtin_amdgcn_mfma_f32_16x16x16bf16_1k(XT, X, z4, 0, 0, 0), x2t = __builtin_amdgcn_mfma_f32_16x16x16bf16_1k(X, XT, z4, 0, 0, 0);
                s16x4v X2 = cvt4(x2), X2T = cvt4(x2t);
                { const s16x4v t1 = cvt4(Tm), t1t = cvt4(TmT);
                  Tm = __builtin_amdgcn_mfma_f32_16x16x16bf16_1k(t1t, X2, Tm, 0, 0, 0); TmT = __builtin_amdgcn_mfma_f32_16x16x16bf16_1k(X2, t1t, TmT, 0, 0, 0); }
                f32x4 x4 = __builtin_amdgcn_mfma_f32_16x16x16bf16_1k(X2T, X2, z4, 0, 0, 0), x4t = __builtin_amdgcn_mfma_f32_16x16x16bf16_1k(X2, X2T, z4, 0, 0, 0);
                s16x4v X4 = cvt4(x4), X4T = cvt4(x4t);
                { const s16x4v t2t = cvt4(TmT);
                  Tm = __builtin_amdgcn_mfma_f32_16x16x16bf16_1k(t2t, X4, Tm, 0, 0, 0); TmT = __builtin_amdgcn_mfma_f32_16x16x16bf16_1k(X4, t2t, TmT, 0, 0, 0); }
                const f32x4 x8 = __builtin_amdgcn_mfma_f32_16x16x16bf16_1k(X4T, X4, z4, 0, 0, 0);
                { const s16x4v t4t = cvt4(TmT), X8 = cvt4(x8);
                  Tm = __builtin_amdgcn_mfma_f32_16x16x16bf16_1k(t4t, X8, Tm, 0, 0, 0); }
                *(LAS s16x4v*)((LAS bf16*)(setp + ST_TT) + l15 * 16 + 4 * q) = cvt4(Tm);
            } else {
                const LAS bf16* Lm = (p == 1) ? ALr : RBr; const LAS bf16* Rm = (p == 2) ? BTr : KTr;
                f32x4 x = z4;
#pragma unroll
                for (int ks = 0; ks < 2; ++ks) x = __builtin_amdgcn_mfma_f32_16x16x32_bf16(*(const LAS bf16x8*)(Lm + 32 * ks + 8 * q), *(const LAS bf16x8*)(Rm + 32 * ks + 8 * q), x, 0, 0, 0);
#pragma unroll
                for (int r = 0; r < 4; ++r) { const int t = 4 * q + r; const bool keep = (p == 1) ? (l15 < t) : (l15 <= t);
                    ((LAS bf16*)(setp + (p == 1 ? ST_BB : (p == 2 ? ST_A2 : ST_B2))))[t * 16 + l15] = f2bfh(keep ? x[r] : 0.f); }
            }
        }
        if (wid < 4 && cons) { SCAN_EPI(); }
        if (wid != 4 && c + 1 < c_hi) SCAN_SHIFT(c + 1);
        { const int cn = c + 2 < c_hi ? c + 2 : c_hi - 1; SCAN_ISSUE(cn); }
        LBAR();
    }
#undef SCAN_SHIFT
#undef SCAN_ITEMS
#undef SCAN_EPI
#undef SCAN_ISSUE
    if (wid < 4 && seg < 3) { float* sg = (float*)(A.ws + WS_SEGS) + (size_t)((chain * 3 + seg) * 2) * 4096 + (16 * wid + l15) * 64 + 4 * q;
#pragma unroll
        for (int m = 0; m < 4; ++m) { *(f32x4*)(sg + 16 * m) = sT[m]; *(f32x4*)(sg + 4096 + 16 * m) = sI[m]; } }
}

__device__ __forceinline__ int crow(int r, int hi) { return (r & 3) + 8 * (r >> 2) + 4 * hi; }
__device__ __forceinline__ int slot_key(int i) { const int i5 = i & 31; return (i & 32) + 16 * ((i5 >> 2) & 1) + (i5 & 3) + 4 * (i5 >> 3); }
constexpr int AT_K = 0, AT_V = 8192, AT_FLAG = 16384;
__device__ __forceinline__ void attn_phase(const Args& A, LAS unsigned char* lds) {
    const int tid = threadIdx.x, lane = tid & 63, r32 = lane & 31, hi = lane >> 5, wid = __builtin_amdgcn_readfirstlane(tid >> 6);
    bf16* Q = (bf16*)(A.ws + WS_PR + 3 * PL); const bf16* K = (const bf16*)(A.ws + WS_PR + 4 * PL); const bf16* V = (const bf16*)(A.ws + WS_PR + 5 * PL);
    LAS float* FLAG = (LAS float*)(lds + AT_FLAG);
    const int vb = (int)(unsigned)(uintptr_t)(lds + AT_V) + ((lane >> 4) & 1) * 32 + (lane & 3) * 8 + (4 * hi + ((lane & 15) >> 2)) * 64;
    const int kslot = slot_key(lane);
    const int vslot = slot_key(16 * (wid & 3) + (lane >> 2));
    unsigned* qctr = (unsigned*)(A.ws + WS_CTL) + 4000;
    LAS int* UQ = (LAS int*)(lds + AT_FLAG + 64);
    for (;;) {
        __syncthreads();
        if (tid == 0) *UQ = (int)atomicAdd(qctr, 1u);
        __syncthreads();
        const int unit = *UQ; if (unit >= NB * NH * 16) break;
        const int bh = unit & 63, qb = 15 - (unit >> 6), b = bh >> 4, h = bh & 15;
        const int tq0 = NMETA + 256 * qb, tqw = tq0 + 32 * wid;
        const int uqw = 256 * qb + 32 * wid, uq = uqw + r32;
        const bf16* Qw = Q + (size_t)(b * SEQ + tqw - NMETA) * 1024 + h * 64;
        bf16x8 qr[4];
#pragma unroll
        for (int d0 = 0; d0 < 4; ++d0) qr[d0] = *(const bf16x8*)(Qw + (size_t)r32 * 1024 + d0 * 16 + hi * 8);
        f32x16 o0 = {}, o1 = {}; float c = 1.f;
        float wcm = 1.f;
        const int jmax = 4 * qb + 3;
        u32x4 kreg, vreg;
#define AT_LOAD(j) do { const size_t rk_ = (j) >= 0 ? (size_t)(b * SEQ + 64 * (j) + kslot) : (size_t)(MR + (kslot < NMETA ? kslot : NMETA - 1)), rv_ = (j) >= 0 ? (size_t)(b * SEQ + 64 * (j) + vslot) : (size_t)(MR + (vslot < NMETA ? vslot : NMETA - 1)); \
            kreg = *(const u32x4*)(K + rk_ * 1024 + h * 64 + 8 * wid); vreg = *(const u32x4*)(V + rv_ * 1024 + h * 64 + (wid >> 2) * 32 + (lane & 3) * 8); } while (0)
        AT_LOAD(jmax);
        if (lane == 0) FLAG[wid] = 1.f;
        for (int j = jmax; j >= -1; --j) {
            __syncthreads();
            { float fm = FLAG[0];
#pragma unroll
              for (int i = 1; i < 8; ++i) fm = fmaxf(fm, FLAG[i]);
              if (fm < 1.17549435e-38f) break; }
            *(LAS u32x4*)(lds + AT_K + wid * 1024 + lane * 16) = kreg; *(LAS u32x4*)(lds + AT_V + wid * 1024 + lane * 16) = vreg;
            { const int jn = j > -1 ? j - 1 : -1; AT_LOAD(jn); }
            __syncthreads();
            if (64 * j > uqw + 31) continue;
            if (wcm < 1.17549435e-38f) continue;
            f32x16 p0 = {}, p1 = {};
            { const LAS unsigned char* kb = lds + AT_K + hi * 1024 + r32 * 16;
#pragma unroll
              for (int d0 = 0; d0 < 4; ++d0) { const bf16x8 b0 = *(const LAS bf16x8*)(kb + d0 * 2048), b1 = *(const LAS bf16x8*)(kb + d0 * 2048 + 512);
                  p0 = __builtin_amdgcn_mfma_f32_32x32x16_bf16(b0, qr[d0], p0, 0, 0, 0); p1 = __builtin_amdgcn_mfma_f32_32x32x16_bf16(b1, qr[d0], p1, 0, 0, 0); } }
            const int kbase = (j >= 0 ? 64 * j : 0) + 16 * hi, tq = j >= 0 ? uq : NMETA;
            float T0 = 1.f, T1 = 1.f;
#define AT_ELEM(MASKED) do { \
            _Pragma("unroll") for (int r = 15; r >= 0; --r) { const float e = __builtin_amdgcn_exp2f(p1[r]); float kp = __builtin_amdgcn_rcpf(1.0f + e), be = 1.0f - kp; \
                if (MASKED) { if (kbase + 32 + r >= tq) { kp = 1.f; be = 0.f; } } p1[r] = be * T1; T1 *= kp; } \
            _Pragma("unroll") for (int r = 15; r >= 0; --r) { const float e = __builtin_amdgcn_exp2f(p0[r]); float kp = __builtin_amdgcn_rcpf(1.0f + e), be = 1.0f - kp; \
                if (MASKED) { if (kbase + r >= tq) { kp = 1.f; be = 0.f; } } p0[r] = be * T0; T0 *= kp; } } while (0)
            if (j < 0 || 64 * j + 63 >= uqw) AT_ELEM(1); else AT_ELEM(0);
#undef AT_ELEM
            float PT0, PT1;
            { auto r0 = __builtin_amdgcn_permlane32_swap(__float_as_uint(T0), __float_as_uint(T0), false, false); PT0 = __uint_as_float(hi ? r0[0] : r0[1]);
              auto r1 = __builtin_amdgcn_permlane32_swap(__float_as_uint(T1), __float_as_uint(T1), false, false); PT1 = __uint_as_float(hi ? r1[0] : r1[1]); }
            const float off0 = c * (hi ? (T1 * PT1) : (PT0 * T1 * PT1)), off1 = c * (hi ? 1.f : PT1);
#pragma unroll
            for (int r = 0; r < 16; ++r) { p0[r] *= off0; p1[r] *= off1; }
            c *= (T0 * T1) * (PT0 * PT1);
            { float cm = c;
              cm = fmaxf(cm, __builtin_bit_cast(float, __builtin_amdgcn_update_dpp(0, __builtin_bit_cast(int, cm), 0xB1, 0xF, 0xF, true)));
              cm = fmaxf(cm, __builtin_bit_cast(float, __builtin_amdgcn_update_dpp(0, __builtin_bit_cast(int, cm), 0x4E, 0xF, 0xF, true)));
              cm = fmaxf(cm, __builtin_bit_cast(float, __builtin_amdgcn_update_dpp(0, __builtin_bit_cast(int, cm), 0x141, 0xF, 0xF, true)));
              cm = fmaxf(cm, __builtin_bit_cast(float, __builtin_amdgcn_update_dpp(0, __builtin_bit_cast(int, cm), 0x140, 0xF, 0xF, true)));
              const float c0 = __builtin_bit_cast(float, __builtin_amdgcn_readlane(__builtin_bit_cast(int, cm), 0)), c1 = __builtin_bit_cast(float, __builtin_amdgcn_readlane(__builtin_bit_cast(int, cm), 16));
              wcm = fmaxf(c0, c1); if (lane == 0) FLAG[wid] = wcm; }
            u32x4 pw0, pw1, pw2, pw3;
            pw0 = (u32x4){pk2(p0[0], p0[1]), pk2(p0[2], p0[3]), pk2(p0[4], p0[5]), pk2(p0[6], p0[7])}; pw1 = (u32x4){pk2(p0[8], p0[9]), pk2(p0[10], p0[11]), pk2(p0[12], p0[13]), pk2(p0[14], p0[15])};
            pw2 = (u32x4){pk2(p1[0], p1[1]), pk2(p1[2], p1[3]), pk2(p1[4], p1[5]), pk2(p1[6], p1[7])}; pw3 = (u32x4){pk2(p1[8], p1[9]), pk2(p1[10], p1[11]), pk2(p1[12], p1[13]), pk2(p1[14], p1[15])};
#pragma unroll
            for (int d0 = 0; d0 < 2; ++d0) { s16x4 lo[4], hh[4];
#pragma unroll
                for (int ks = 0; ks < 4; ++ks) {
                    asm volatile("ds_read_b64_tr_b16 %0,%1 offset:%c2" : "=&v"(lo[ks]) : "v"(vb), "i"(d0 * 4096 + ks * 1024) : "memory");
                    asm volatile("ds_read_b64_tr_b16 %0,%1 offset:%c2" : "=&v"(hh[ks]) : "v"(vb), "i"(d0 * 4096 + ks * 1024 + 512) : "memory"); }
                asm volatile("s_waitcnt lgkmcnt(0)" ::: "memory"); __builtin_amdgcn_sched_barrier(0);
#define PKV(k) (bf16x8){lo[k][0], lo[k][1], lo[k][2], lo[k][3], hh[k][0], hh[k][1], hh[k][2], hh[k][3]}
                f32x16& o = d0 ? o1 : o0;
                o = __builtin_amdgcn_mfma_f32_32x32x16_bf16(__builtin_bit_cast(bf16x8, pw0), PKV(0), o, 0, 0, 0);
                o = __builtin_amdgcn_mfma_f32_32x32x16_bf16(__builtin_bit_cast(bf16x8, pw1), PKV(1), o, 0, 0, 0);
                o = __builtin_amdgcn_mfma_f32_32x32x16_bf16(__builtin_bit_cast(bf16x8, pw2), PKV(2), o, 0, 0, 0);
                o = __builtin_amdgcn_mfma_f32_32x32x16_bf16(__builtin_bit_cast(bf16x8, pw3), PKV(3), o, 0, 0, 0);
#undef PKV
            }
        }
#undef AT_LOAD
        bf16* Ow = Q + (size_t)(b * SEQ + tqw - NMETA) * 1024 + h * 64;
#pragma unroll
        for (int r = 0; r < 16; ++r) { const int orow = crow(r, hi); Ow[(size_t)orow * 1024 + r32] = (bf16)f2bf(o0[r]); Ow[(size_t)orow * 1024 + 32 + r32] = (bf16)f2bf(o1[r]); }
        __syncthreads();
    }
}

__device__ __forceinline__ void corr_phase(const Args& A, LAS unsigned char* lds) {
    const int tid = threadIdx.x, lane = tid & 63, wid = __builtin_amdgcn_readfirstlane(tid >> 6), l15 = lane & 15, q = lane >> 4;
    LAS float* SA = (LAS float*)lds; LAS float* SB = SA + 4096;
    bf16* YR = (bf16*)((unsigned char*)A.out + DO_YR); const float* BONUS = (const float*)(A.ws + WS_BONUS);
    const bf16* V = (const bf16*)(A.ws + WS_PR + 2 * PL); const float* SEGS = (const float*)(A.ws + WS_SEGS);
    for (int task = blockIdx.x; task < NB * NH * 4; task += gridDim.x) {
        const int chain = task >> 2, seg = task & 3, b = chain >> 4, h = chain & 15;
        const int c_lo = seg ? SEG_C0 + 64 * (seg - 1) : 0, c_hi = SEG_C0 + 64 * seg;
        const bf16* Wc = (const bf16*)(chain < 33 ? (unsigned char*)A.out + (size_t)chain * WCH : (chain < 60 ? A.ws + WS_END + (size_t)(chain - 33) * WCH : (unsigned char*)A.out + DO_WTAIL + (size_t)(chain - 60) * WCH));
        __syncthreads();
        for (int i = tid; i < 4096; i += 512) SA[i] = seg ? SEGS[(size_t)((chain * 3) * 2) * 4096 + i] : 0.f;
        __syncthreads();
        LAS float* cur = SA; LAS float* nxt = SB;
        for (int s2 = 1; s2 < seg; ++s2) {
            const float* S0 = SEGS + (size_t)((chain * 3 + s2) * 2) * 4096; const float* Cm = S0 + 4096;
            const int row = tid >> 3, kb = (tid & 7) * 8;
            f32x4 a0 = *(const f32x4*)(S0 + row * 64 + kb), a1 = *(const f32x4*)(S0 + row * 64 + kb + 4);
#pragma unroll 8
            for (int j = 0; j < 64; ++j) { const float s = cur[row * 64 + j]; const f32x4 c0 = *(const f32x4*)(Cm + j * 64 + kb), c1 = *(const f32x4*)(Cm + j * 64 + kb + 4); a0 += c0 * s; a1 += c1 * s; }
            *(LAS f32x4*)(nxt + row * 64 + kb) = a0; *(LAS f32x4*)(nxt + row * 64 + kb + 4) = a1;
            __syncthreads();
            LAS float* tsw = cur; cur = nxt; nxt = tsw;
        }
        bf16x8 sinB[4][2];
#pragma unroll
        for (int m = 0; m < 4; ++m)
#pragma unroll
            for (int ks = 0; ks < 2; ++ks) { const LAS float* sp = cur + (16 * m + l15) * 64 + 32 * ks + 8 * q; const s16x4v c0 = cvt4(*(const LAS f32x4*)sp), c1 = cvt4(*(const LAS f32x4*)(sp + 4));
                sinB[m][ks] = (bf16x8){c0[0], c0[1], c0[2], c0[3], c1[0], c1[1], c1[2], c1[3]}; }
        const int colb = h * 64 + l15;
        float mv[4], gg[4], gb[4];
#pragma unroll
        for (int m = 0; m < 4; ++m) { mv[m] = A.mu[2048 + colb + 16 * m]; gg[m] = A.gn_g[colb + 16 * m]; gb[m] = A.gn_b[colb + 16 * m]; }
        const int cfirst = c_lo > 1 ? c_lo : 1;
#define CORR_LOAD(ck, W0, W1, YV, VT, VP, BN) do { \
            const bf16* wr_ = seg ? Wc + (size_t)(((ck) - SEG_C0) * CS + l15) * 64 + 8 * q : (const bf16*)SEGS; W0 = *(const bf16x8*)wr_; W1 = *(const bf16x8*)(wr_ + 32); \
            _Pragma("unroll") for (int r = 0; r < 4; ++r) { const int tg_ = (ck) * CS + 4 * q + r; const size_t row_ = (size_t)(b * SEQ + tg_ - NMETA), prow_ = (tg_ == NMETA) ? (size_t)(MR + NMETA - 1) : row_ - 1; \
                BN[r] = BONUS[row_ * 16 + h]; \
                _Pragma("unroll") for (int m = 0; m < 4; ++m) { YV[r][m] = YR[row_ * 1024 + colb + 16 * m]; VT[r][m] = V[row_ * 1024 + colb + 16 * m]; VP[r][m] = V[prow_ * 1024 + colb + 16 * m]; } } } while (0)
        const int nit = (c_hi - cfirst - wid + 7) / 8;
        if (nit > 0) {
            bf16x8 w0c, w1c; bf16 yc[4][4], vtc[4][4], vpc[4][4]; float bnc[4];
            CORR_LOAD(cfirst + wid, w0c, w1c, yc, vtc, vpc, bnc);
            for (int it = 0; it < nit; ++it) {
                const int chk = cfirst + wid + 8 * it, cn = (it + 1 < nit) ? chk + 8 : chk;
                bf16x8 w0n, w1n; bf16 yn[4][4], vtn[4][4], vpn[4][4]; float bnn[4];
                CORR_LOAD(cn, w0n, w1n, yn, vtn, vpn, bnn);
                f32x4 acc[4];
#pragma unroll
                for (int m = 0; m < 4; ++m) acc[m] = (f32x4){0.f, 0.f, 0.f, 0.f};
                if (seg) {
#pragma unroll
                    for (int m = 0; m < 4; ++m) { acc[m] = __builtin_amdgcn_mfma_f32_16x16x32_bf16(w0c, sinB[m][0], acc[m], 0, 0, 0); acc[m] = __builtin_amdgcn_mfma_f32_16x16x32_bf16(w1c, sinB[m][1], acc[m], 0, 0, 0); } }
#pragma unroll
                for (int r = 0; r < 4; ++r) { const int tg = chk * CS + 4 * q + r; const size_t row = (size_t)(b * SEQ + tg - NMETA);
                    float y[4]; float s = 0.f;
#pragma unroll
                    for (int m = 0; m < 4; ++m) { y[m] = bflo((unsigned)yc[r][m]) + acc[m][r]; s += y[m]; }
                    const float mean = dpp_sum16(s) * (1.f / 64.f); float sq = 0.f;
#pragma unroll
                    for (int m = 0; m < 4; ++m) { y[m] -= mean; sq += y[m] * y[m]; }
                    const float rstd = __builtin_amdgcn_rsqf(dpp_sum16(sq) * (1.f / 64.f) + 64e-5f);
#pragma unroll
                    for (int m = 0; m < 4; ++m) { const float vt = bflo((unsigned)vtc[r][m]), vp = bflo((unsigned)vpc[r][m]); const float vs = vt + (vp - vt) * mv[m]; YR[row * 1024 + colb + 16 * m] = f2bfh(y[m] * rstd * gg[m] + gb[m] + bnc[r] * vs); }
                }
                w0c = w0n; w1c = w1n;
#pragma unroll
                for (int r = 0; r < 4; ++r) { bnc[r] = bnn[r];
#pragma unroll
                    for (int m = 0; m < 4; ++m) { yc[r][m] = yn[r][m]; vtc[r][m] = vtn[r][m]; vpc[r][m] = vpn[r][m]; } }
            }
        }
#undef CORR_LOAD
    }
}

__device__ __forceinline__ void final_phase(const Args& A) {
    const int tid = threadIdx.x, lane = tid & 63, wave = tid >> 6;
    const bf16* RES = (const bf16*)(A.ws + WS_PR); const float* SSP = (const float*)(A.ws + WS_SSP);
    for (int m0 = blockIdx.x * 8 + wave; m0 < MR; m0 += gridDim.x * 16) {
        f32x4 xv[2][4], rv[2][4]; float ss[2] = {0.f, 0.f};
#pragma unroll
        for (int u = 0; u < 2; ++u) { const int m = m0 + u * gridDim.x * 8; if (m < MR) {
            const f32x4* xr = (const f32x4*)(A.x + (size_t)m * 1024) + lane; const unsigned long long* rr = (const unsigned long long*)(RES + (size_t)m * 1024) + lane;
#pragma unroll
            for (int j = 0; j < 4; ++j) { xv[u][j] = __builtin_nontemporal_load(xr + 64 * j); const unsigned long long w = __builtin_nontemporal_load(rr + 64 * j); const unsigned lo = (unsigned)w, hi = (unsigned)(w >> 32); rv[u][j] = (f32x4){bflo(lo), bfhi(lo), bflo(hi), bfhi(hi)}; }
            const f32x4* sp = (const f32x4*)(SSP + (size_t)m * 16);
#pragma unroll
            for (int i = 0; i < 4; ++i) { const f32x4 t = sp[i]; ss[u] += (t[0] + t[1]) + (t[2] + t[3]); } } }
#pragma unroll
        for (int u = 0; u < 2; ++u) { const int m = m0 + u * gridDim.x * 8; if (m < MR) {
            const float inv = __builtin_amdgcn_rsqf(ss[u] * (1.f / 1024.f) + 1e-6f);
            const f32x4* gr = (const f32x4*)A.post_g + lane; f32x4* orow = (f32x4*)(A.out + (size_t)m * 1024) + lane;
#pragma unroll
            for (int j = 0; j < 4; ++j) __builtin_nontemporal_store(xv[u][j] + rv[u][j] * inv * gr[64 * j], orow + 64 * j); } }
    }
}

#define XB_TMO      128
#define XB_XCNT(j)  (256  + 64 * (j))
#define XB_XSUB(j)  (1280 + 64 * (j))
#define XB_XGEN(j)  (2304 + 64 * (j))
#define XB_TOP      3328
#define XB_TOPGEN   3392
#define XCD_BAR_WORDS 3456
#define XB_SPIN_CAP (1u << 18)

__device__ __forceinline__ unsigned xb_ld(unsigned* p)              { return __hip_atomic_load(p, __ATOMIC_RELAXED, __HIP_MEMORY_SCOPE_AGENT); }
__device__ __forceinline__ unsigned xb_add(unsigned* p, unsigned v) { return __hip_atomic_fetch_add(p, v, __ATOMIC_RELAXED, __HIP_MEMORY_SCOPE_AGENT); }
__device__ __forceinline__ unsigned xb_xcc_id() { return (unsigned)__builtin_amdgcn_s_getreg((3 << 11) | 20) & 0xFu; }
#define XB_SPIN(cond, bar) do { unsigned _sp = 0; while (cond) { __builtin_amdgcn_s_sleep(1); \
    if ((++_sp & 255u) == 0u) { if (xb_ld(&(bar)[XB_TMO])) break; if (_sp > XB_SPIN_CAP) { atomicAdd(&(bar)[XB_TMO], 1u); break; } } } } while (0)

struct XcdBarrier {
    unsigned* bar; unsigned x;
    volatile LAS unsigned* st;
};

__device__ __forceinline__ XcdBarrier xcd_barrier_post(unsigned* bar, volatile LAS unsigned* st) {
    XcdBarrier b; b.bar = bar; b.x = xb_xcc_id(); b.st = st;
    if (threadIdx.x == 0) (void)xb_add(&bar[XB_XCNT(b.x)], 1u);
    return b;
}
__device__ __forceinline__ void xcd_barrier_complete(unsigned* bar, unsigned x, unsigned& nloc, unsigned& nx) {
    const unsigned G = gridDim.x * gridDim.y * gridDim.z;
    unsigned sum, cnt, mine, sp = 0u;
    for (;;) {
        sum = 0u; cnt = 0u; mine = 0u;
#pragma unroll
        for (unsigned j = 0; j < 16; ++j) { const unsigned c = xb_ld(&bar[XB_XCNT(j)]); sum += c; cnt += (c > 0u) ? 1u : 0u; mine = (j == x) ? c : mine; }
        if (sum == G) break;
        __builtin_amdgcn_s_sleep(1);
        if ((++sp & 255u) == 0u) { if (xb_ld(&bar[XB_TMO])) break; if (sp > XB_SPIN_CAP) { atomicAdd(&bar[XB_TMO], 1u); break; } }
    }
    nloc = mine > 0u ? mine : 1u; nx = cnt > 0u ? cnt : 1u;
}

__device__ __forceinline__ void xcd_barrier(const XcdBarrier& b) {
    asm volatile("s_waitcnt vmcnt(0)" ::: "memory");
    __syncthreads();
    if (threadIdx.x == 0) {
        unsigned* bar = b.bar;
        __builtin_amdgcn_s_waitcnt(0);
        unsigned nloc = b.st[0], nx = b.st[1];
        if (nloc == 0u) { xcd_barrier_complete(bar, b.x, nloc, nx); b.st[0] = nloc; b.st[1] = nx; }
        const unsigned old = xb_add(&bar[XB_XSUB(b.x)], 1u);
        const unsigned gen = old / nloc;
        if (old + 1u == (gen + 1u) * nloc) {
            __builtin_amdgcn_fence(__ATOMIC_RELEASE, "agent");
            asm volatile("s_waitcnt vmcnt(0)" ::: "memory");
            const unsigned og = xb_add(&bar[XB_TOP], 1u);
            const unsigned tg = og / nx;
            if (og + 1u == (tg + 1u) * nx) xb_add(&bar[XB_TOPGEN], 1u);
            else XB_SPIN(xb_ld(&bar[XB_TOPGEN]) == tg, bar);
            __builtin_amdgcn_fence(__ATOMIC_ACQUIRE, "agent");
            xb_add(&bar[XB_XGEN(b.x)], 1u);
            asm volatile("s_waitcnt vmcnt(0)" ::: "memory");
        } else {
            XB_SPIN(xb_ld(&bar[XB_XGEN(b.x)]) == gen, bar);
            __builtin_amdgcn_fence(__ATOMIC_ACQUIRE, "agent");
            asm volatile("s_waitcnt vmcnt(0)" ::: "memory");
        }
    }
    __syncthreads();
}

constexpr int NPH = 9;
__global__ void __launch_bounds__(512, 2) fwd_kernel(Args A) {
    extern __shared__ __attribute__((aligned(16))) unsigned char lds_raw[];
    LAS unsigned char* lds = (LAS unsigned char*)lds_raw;
    unsigned char* ws = A.ws; unsigned char* dob = (unsigned char*)A.out;
    const bf16* XN = (const bf16*)(ws + WS_XN); const bf16* WTIN = (const bf16*)(dob + DO_WTIN);
    bf16* P0 = (bf16*)(ws + WS_PR);
#define IN(k) (A.ph_lo <= (k) && (k) < A.ph_hi)
    if (threadIdx.x < 16) ((LAS unsigned*)(lds + LDS_XB))[threadIdx.x] = 0u;
    __syncthreads();
    const XcdBarrier xbar = xcd_barrier_post((unsigned*)(ws + WS_CTL), (volatile LAS unsigned*)(lds + LDS_XB));
#define SEAM(k) do { if (IN(k) && IN((k) + 1)) xcd_barrier(xbar); } while (0)
    if (IN(0)) p0_prologue(A, lds, false, 0, 1);
    SEAM(0);
    if (IN(1)) {
        pg8::Gemm g{XN, WTIN, MP, N1, 1024}; pg8::StaticOrder S; S.init(MP, N1, gridDim.x, blockIdx.x);
        pg8::EpiStore E{P0, PL / 2, 3, QSCALE, 24, (bf16*)(ws + WS_LORA)};
        pg8::gemm_phase<pg8::EpiStore, pg8::StaticOrder, true, true>(lds, g, S, E);
        { const int nun = (MP / 256) * (N1 / 256), rem = nun % (int)gridDim.x; const int first = (rem > 0 && rem < (int)gridDim.x) ? rem : 0;
          __syncthreads();
          if ((int)blockIdx.x >= first) p0_prologue(A, lds, true, ((int)blockIdx.x - first) * 8 + (int)(threadIdx.x >> 6), ((int)gridDim.x - first) * 8); }
    }
    SEAM(1);
    if (IN(2)) { for (int task = blockIdx.x; task < NB * NH * 4; task += gridDim.x) scan_chain(A, lds, task >> 2, task & 3); __syncthreads(); attn_phase(A, lds); }
    SEAM(2);
    if (IN(3)) corr_phase(A, lds);
    SEAM(3);
    if (IN(4)) {
        pg8::Gemm g{XN, WTIN + (size_t)6400 * 1024, MR, 2048, 1024}; pg8::StaticOrder S; S.init(MR, 2048, gridDim.x, blockIdx.x);
        pg8::EpiGate E{(bf16*)(dob + DO_YR), P0 + 3 * (PL / 2)};
        pg8::gemm_phase<pg8::EpiGate, pg8::StaticOrder, true, true>(lds, g, S, E);
    }
    SEAM(4);
    if (IN(5)) {
        { pg8::Gemm g{(const bf16*)(dob + DO_YR), (const bf16*)(dob + DO_WPR), MR, 1024, 1024}; pg8::StaticOrder S; S.init(MR, 1024, gridDim.x, blockIdx.x);
          pg8::EpiStore E{P0 + 1 * (PL / 2), 0, -1, 1.f, -1, nullptr}; pg8::gemm_phase<pg8::EpiStore, pg8::StaticOrder, true, true>(lds, g, S, E); }
        { pg8::Gemm g{P0 + 3 * (PL / 2), (const bf16*)(dob + DO_WPS), MR, 1024, 1024}; pg8::StaticOrder S; S.init(MR, 1024, gridDim.x, blockIdx.x);
          pg8::EpiStore E{P0 + 4 * (PL / 2), 0, -1, 1.f, -1, nullptr}; pg8::gemm_phase<pg8::EpiStore, pg8::StaticOrder, true, true>(lds, g, S, E); }
    }
    SEAM(5);
    if (IN(6)) {
        pg8::Gemm g{XN, WTIN + (size_t)8448 * 1024, MR, 2048, 1024}; pg8::StaticOrder S; S.init(MR, 2048, gridDim.x, blockIdx.x);
        pg8::EpiMerge E{P0 + 1 * (PL / 2), P0 + 4 * (PL / 2), P0 + 2 * (PL / 2)};
        pg8::gemm_phase<pg8::EpiMerge, pg8::StaticOrder, true, true>(lds, g, S, E);
    }
    SEAM(6);
    if (IN(7)) {
        pg8::Gemm g{P0 + 2 * (PL / 2), (const bf16*)(dob + DO_WOUT), MR, 1024, 1024}; pg8::StaticOrder S; S.init(MR, 1024, gridDim.x, blockIdx.x);
        pg8::EpiOut E{(bf16*)(ws + WS_PR), (float*)(ws + WS_SSP)};
        pg8::gemm_phase<pg8::EpiOut, pg8::StaticOrder, true, true>(lds, g, S, E);
    }
    SEAM(7);
    if (IN(8)) final_phase(A);
#undef IN
#undef SEAM
}

#ifndef N_LAUNCHES
#define N_LAUNCHES 1
#endif
extern "C" void kernel_launch(void* const* d_in, const int* in_sizes, int n_in, void* d_out, int out_size, void* d_ws, size_t ws_size, hipStream_t stream) {
    static int grid = 0;
    if (grid == 0) {
        int dev = 0, cus = 0, per_cu = 0;
        hipGetDevice(&dev); hipDeviceGetAttribute(&cus, hipDeviceAttributeMultiprocessorCount, dev);
        hipFuncSetAttribute((const void*)fwd_kernel, hipFuncAttributeMaxDynamicSharedMemorySize, LDS_BYTES);
        if (hipOccupancyMaxActiveBlocksPerMultiprocessor(&per_cu, (const void*)fwd_kernel, 512, LDS_BYTES) != hipSuccess || per_cu < 1) per_cu = 1;
        (void)hipGetLastError();
        grid = cus * per_cu; if (grid > 256) grid = 256;
        if (n_in != 18 || ws_size < WS_END) { fprintf(stderr, "kernel_launch: unexpected inputs (n_in %d, ws %zu)\n", n_in, ws_size); }
    }
    (void)hipMemsetAsync((unsigned char*)d_ws + WS_CTL, 0, CTL_BYTES, stream);
    Args a{};
    const float** pf = (const float**)&a;
    for (int i = 0; i < 18; ++i) pf[i] = (const float*)d_in[i];
    a.out = (float*)d_out; a.ws = (unsigned char*)d_ws;
    for (int li = 0; li < N_LAUNCHES; ++li) {
        a.ph_lo = (N_LAUNCHES == 1) ? 0 : li; a.ph_hi = (N_LAUNCHES == 1) ? NPH : li + 1;
        void* args[] = {&a};
        hipError_t e = hipLaunchCooperativeKernel((const void*)fwd_kernel, dim3(grid), dim3(512), args, LDS_BYTES, stream);
        if (e != hipSuccess) { fprintf(stderr, "cooperative launch failed: %s (grid %d)\n", hipGetErrorString(e), grid); break; }
    }
}
```
